# Optimizing an MI355X kernel written in HIP

```python
import math
import jax
import jax.numpy as jnp
from jax import lax
import numpy as np

D_MODEL = 2048
BATCH = 4
SEQ = 2048
DEPTH = 4
DEC_BATCH = 32
DEC_SEQ = 8
PAST_LEN = 16384
PAGE_SIZE = 128

HEAD_DIM = 64
A_DIM = D_MODEL // 4
B_DIM = D_MODEL // 4
C_DIM = D_MODEL // 2
A_HEADS = A_DIM // HEAD_DIM
B_HEADS = B_DIM // HEAD_DIM
C_Q_HEADS = C_DIM // HEAD_DIM
C_KV_HEADS = 2
C_GROUP = C_Q_HEADS // C_KV_HEADS
MIX_DIM = A_DIM + B_DIM + C_DIM
C_KV_DIM = C_KV_HEADS * HEAD_DIM
A_BRANCHES = ((128, 1), (512, 4), (2048, 16))
A_MAX_WINDOW = 2048
C_WINDOW = 128
BLOCK = 128
ROPE_THETA = 500000.0
ROPE_DIM = HEAD_DIM // 4
B_DECAY_LORA = 96
B_AAA_LORA = 96
B_GATE_LORA = 64
B_COLS = 3 * B_DIM + B_DECAY_LORA + B_AAA_LORA + B_GATE_LORA
IN_COLS = 3 * A_DIM + B_COLS + C_DIM + 2 * C_KV_DIM
IN_SPLITS = (A_DIM, 2 * A_DIM, 3 * A_DIM, 3 * A_DIM + B_COLS, 3 * A_DIM + B_COLS + C_DIM, 3 * A_DIM + B_COLS + C_DIM + C_KV_DIM)
B_SPLITS = (B_DIM, 2 * B_DIM, 3 * B_DIM, 3 * B_DIM + B_DECAY_LORA, 3 * B_DIM + B_DECAY_LORA + B_AAA_LORA)
D_FF = -(-8 * D_MODEL // (3 * 256)) * 256
RMS_EPS = 1e-6
GN_EPS = 64e-5
ATTN_SCALE = HEAD_DIM ** -0.5

kernel_name = 'hybrid_dilated_rwkv7_swa_decoder_step'


def rms_norm(x, g):
    xf = x.astype(jnp.float32)
    y = xf * lax.rsqrt(jnp.mean(xf * xf, axis=-1, keepdims=True) + RMS_EPS)
    return (y * g.astype(jnp.float32)).astype(x.dtype)


def rope_partial(x, pos):
    half = ROPE_DIM // 2
    inv = jnp.exp(-math.log(ROPE_THETA) * jnp.arange(half, dtype=jnp.float32) * 2.0 / ROPE_DIM)
    ang = pos.astype(jnp.float32)[:, None] * inv[None, :]
    shp = (ang.shape[0],) + (1,) * (x.ndim - 3) + (half,)
    cos = jnp.cos(ang).reshape(shp).astype(x.dtype)
    sin = jnp.sin(ang).reshape(shp).astype(x.dtype)
    x1 = x[..., :half]
    x2 = x[..., half:ROPE_DIM]
    return jnp.concatenate([x1 * cos - x2 * sin, x2 * cos + x1 * sin, x[..., ROPE_DIM:]], axis=-1)


def band_attention(q, k, v, window):
    B, L, Hk, G, hd = q.shape
    Lp = -(-L // BLOCK) * BLOCK
    pad = Lp - L
    if pad:
        q = jnp.pad(q, [(0, 0), (0, pad), (0, 0), (0, 0), (0, 0)])
        k = jnp.pad(k, [(0, 0), (0, pad), (0, 0), (0, 0)])
        v = jnp.pad(v, [(0, 0), (0, pad), (0, 0), (0, 0)])
    nb = Lp // BLOCK
    qb = q.reshape(B, nb, BLOCK, Hk, G, hd)
    kb = k.reshape(B, nb, BLOCK, Hk, hd)
    vb = v.reshape(B, nb, BLOCK, Hk, hd)
    k2 = jnp.concatenate([jnp.concatenate([jnp.zeros_like(kb[:, :1]), kb[:, :-1]], axis=1), kb], axis=2)
    v2 = jnp.concatenate([jnp.concatenate([jnp.zeros_like(vb[:, :1]), vb[:, :-1]], axis=1), vb], axis=2)
    s = jnp.einsum('bnqhgd,bnkhd->bnhgqk', qb, k2, preferred_element_type=jnp.float32) * ATTN_SCALE
    kpos = jnp.arange(2 * BLOCK)
    dist = (jnp.arange(BLOCK) + BLOCK)[:, None] - kpos[None, :]
    band = (dist >= 0) & (dist <= window)
    has_prev = (jnp.arange(nb)[:, None, None] > 0) | (kpos[None, None, :] >= BLOCK)
    mask = band[None] & has_prev
    s = jnp.where(mask[None, :, None, None], s, -jnp.inf)
    lse = jax.nn.logsumexp(s, axis=-1)
    p = jnp.exp(s - lse[..., None]).astype(v.dtype)
    o = jnp.einsum('bnhgqk,bnkhd->bnqhgd', p, v2).reshape(B, Lp, Hk, G, hd)[:, :L]
    lse = lse.transpose(0, 1, 4, 2, 3).reshape(B, Lp, Hk, G)[:, :L]
    return o, lse


def combine_branches(outs, lses):
    wts = jax.nn.softmax(jnp.stack(lses, axis=0), axis=0)
    o = jnp.stack(outs, axis=0).astype(jnp.float32)
    return jnp.sum(wts[..., None] * o, axis=0).astype(outs[0].dtype)


def dilated_attention_prompt(q, k, v):
    B, L, H, hd = q.shape
    outs, lses = [], []
    for window, dil in A_BRANCHES:
        Ls = L // dil

        def to_sub(t):
            return t.reshape(B, Ls, dil, H, hd).transpose(0, 2, 1, 3, 4).reshape(B * dil, Ls, H, hd)

        o, lse = band_attention(to_sub(q)[:, :, :, None, :], to_sub(k), to_sub(v), window // dil)
        outs.append(o[:, :, :, 0].reshape(B, dil, Ls, H, hd).transpose(0, 2, 1, 3, 4).reshape(B, L, H, hd))
        lses.append(lse[..., 0].reshape(B, dil, Ls, H).transpose(0, 2, 1, 3).reshape(B, L, H))
    return combine_branches(outs, lses)


def dilated_attention_sample(q, k_all, v_all, n_buf):
    T = q.shape[1]
    qi = n_buf + jnp.arange(T)
    outs, lses = [], []
    for window, dil in A_BRANCHES:
        n_keys = window // dil + 1
        idx = qi[:, None] - dil * jnp.arange(n_keys)[None, :]
        valid = idx >= 0
        idx = jnp.maximum(idx, 0)
        kg = k_all[:, idx]
        vg = v_all[:, idx]
        s = jnp.einsum('bthd,btjhd->bthj', q, kg, preferred_element_type=jnp.float32) * ATTN_SCALE
        s = jnp.where(valid[None, :, None, :], s, -jnp.inf)
        lse = jax.nn.logsumexp(s, axis=-1)
        p = jnp.exp(s - lse[..., None]).astype(vg.dtype)
        outs.append(jnp.einsum('bthj,btjhd->bthd', p, vg))
        lses.append(lse)
    return combine_branches(outs, lses)


def apply_sink(o, lse, sink):
    scale = jax.nn.sigmoid(lse - sink.astype(jnp.float32))
    return (o.astype(jnp.float32) * scale[..., None]).astype(o.dtype)


def window_attention_prompt(q, k, v, sink):
    o, lse = band_attention(q, k, v, C_WINDOW)
    return apply_sink(o, lse, sink)


def window_attention_sample(q, k_all, v_all, n_buf, sink):
    T = q.shape[1]
    M = k_all.shape[1]
    dist = (n_buf + jnp.arange(T))[:, None] - jnp.arange(M)[None, :]
    mask = (dist >= 0) & (dist <= C_WINDOW)
    s = jnp.einsum('bthgd,bmhd->bhgtm', q, k_all, preferred_element_type=jnp.float32) * ATTN_SCALE
    s = jnp.where(mask, s, -jnp.inf)
    lse = jax.nn.logsumexp(s, axis=-1)
    p = jnp.exp(s - lse[..., None]).astype(v_all.dtype)
    o = jnp.einsum('bhgtm,bmhd->bthgd', p, v_all)
    return apply_sink(o, lse.transpose(0, 3, 1, 2), sink)


def rwkv7_time_mix(pb, pb_prev, s0, mu, w0, w2, a0, a2, g2, k_k, k_a, r_k, lnx_w, lnx_b):
    f32 = jnp.float32
    B, L, _ = pb.shape
    p = pb.astype(f32)
    shifted = jnp.concatenate([pb_prev.astype(f32)[:, None], p[:, :-1]], axis=1)
    p = p + (shifted - p) * mu.astype(f32)
    r, k, v, wl, al, gl = jnp.split(p, B_SPLITS, axis=-1)
    w = -jax.nn.softplus(-(w0.astype(f32) + jnp.tanh(wl) @ w2.astype(f32))) - 0.5
    decay = jnp.exp(-jnp.exp(w))
    a = jax.nn.sigmoid(a0.astype(f32) + al @ a2.astype(f32))
    g = jax.nn.sigmoid(gl) @ g2.astype(f32)

    def heads(t):
        return t.reshape(B, L, B_HEADS, HEAD_DIM)

    kk = heads(k * k_k.astype(f32))
    kk = kk / jnp.maximum(jnp.sqrt(jnp.sum(kk * kk, axis=-1, keepdims=True)), 1e-12)
    k = k * (1.0 + (a - 1.0) * k_a.astype(f32))
    r_h, k_h, v_h, d_h, a_h = heads(r), heads(k), heads(v), heads(decay), heads(a)
    b_h = kk * a_h

    def step(S, inp):
        r_t, d_t, k_t, v_t, kk_t, b_t = inp
        sa = jnp.einsum('bhij,bhj->bhi', S, -kk_t)
        S = S * d_t[:, :, None, :] + sa[..., None] * b_t[:, :, None, :] + v_t[..., None] * k_t[:, :, None, :]
        return S, jnp.einsum('bhij,bhj->bhi', S, r_t)

    xs = tuple(jnp.moveaxis(t, 1, 0) for t in (r_h, d_h, k_h, v_h, kk, b_h))
    S, y = lax.scan(step, s0.astype(f32), xs)
    y = jnp.moveaxis(y, 0, 1)
    mean = jnp.mean(y, axis=-1, keepdims=True)
    var = jnp.mean(jnp.square(y - mean), axis=-1, keepdims=True)
    y = ((y - mean) * lax.rsqrt(var + GN_EPS)).reshape(B, L, B_DIM) * lnx_w.astype(f32) + lnx_b.astype(f32)
    bonus = jnp.sum(r_h * k_h * r_k.astype(f32).reshape(B_HEADS, HEAD_DIM), axis=-1, keepdims=True) * v_h
    y = (y + bonus.reshape(B, L, B_DIM)) * g
    return y.astype(pb.dtype), S.astype(pb.dtype), pb[:, -1]


def trunk_layer(x, pos, lw, past):
    (g_mix, w_in, w_out, mu, w0, w2, a0, a2, g2, k_k, k_a, r_k, lnx_w, lnx_b,
     sink, g_ffn, w_gate, w_up, w_down) = lw
    nb, L, _ = x.shape
    h = rms_norm(x, g_mix)
    p = h @ w_in
    qa, ka, va, pb, qc, kc, vc = jnp.split(p, IN_SPLITS, axis=-1)
    qa = rope_partial(qa.reshape(nb, L, A_HEADS, HEAD_DIM), pos)
    ka = rope_partial(ka.reshape(nb, L, A_HEADS, HEAD_DIM), pos)
    va = va.reshape(nb, L, A_HEADS, HEAD_DIM)
    qc = rope_partial(qc.reshape(nb, L, C_KV_HEADS, C_GROUP, HEAD_DIM), pos)
    kc = rope_partial(kc.reshape(nb, L, C_KV_HEADS, HEAD_DIM), pos)
    vc = vc.reshape(nb, L, C_KV_HEADS, HEAD_DIM)
    rwkv_w = (mu, w0, w2, a0, a2, g2, k_k, k_a, r_k, lnx_w, lnx_b)
    if past is None:
        oa = dilated_attention_prompt(qa, ka, va)
        oc = window_attention_prompt(qc, kc, vc, sink)
        ob, wkv, shift = rwkv7_time_mix(pb, jnp.zeros((nb, B_COLS), p.dtype),
                                        jnp.zeros((nb, B_HEADS, HEAD_DIM, HEAD_DIM), jnp.float32), *rwkv_w)
        a_keep = min(A_MAX_WINDOW, L)
        c_keep = min(C_WINDOW, L)
        new = (ka[:, L - a_keep:], va[:, L - a_keep:], kc[:, L - c_keep:], vc[:, L - c_keep:], wkv, shift)
    else:
        a_k_buf, a_v_buf, c_k_buf, c_v_buf, wkv0, shift0 = past
        oa = dilated_attention_sample(qa, jnp.concatenate([a_k_buf.astype(ka.dtype), ka], axis=1),
                                      jnp.concatenate([a_v_buf.astype(va.dtype), va], axis=1), a_k_buf.shape[1])
        oc = window_attention_sample(qc, jnp.concatenate([c_k_buf.astype(kc.dtype), kc], axis=1),
                                     jnp.concatenate([c_v_buf.astype(vc.dtype), vc], axis=1), c_k_buf.shape[1], sink)
        ob, wkv, shift = rwkv7_time_mix(pb, shift0, wkv0, *rwkv_w)
        new = (ka, va, kc, vc, wkv, shift)
    mixed = jnp.concatenate([oa.reshape(nb, L, A_DIM), ob, oc.reshape(nb, L, C_DIM)], axis=-1)
    x = x + mixed @ w_out
    h = rms_norm(x, g_ffn)
    x = x + (jax.nn.silu(h @ w_gate) * (h @ w_up)) @ w_down
    return x, new


def setup_inputs(seed: int = 0) -> dict:
    key = jax.random.key(seed)
    ks = jax.random.split(key, 32)
    f32 = jnp.float32
    a_win = min(A_MAX_WINDOW, PAST_LEN)
    c_win = min(C_WINDOW, PAST_LEN)

    def nrm(k, shape, scale):
        return jax.random.normal(k, shape, f32) * scale

    return {
        'x_prompt': nrm(ks[0], (BATCH, SEQ, D_MODEL), 1.0),
        'x_sample': nrm(ks[1], (DEC_BATCH, DEC_SEQ, D_MODEL), 1.0),
        'cache_a_k': nrm(ks[2], (DEPTH, DEC_BATCH, a_win, A_HEADS, HEAD_DIM), 1.0),
        'cache_a_v': nrm(ks[3], (DEPTH, DEC_BATCH, a_win, A_HEADS, HEAD_DIM), 1.0),
        'cache_c_k': nrm(ks[4], (DEPTH, DEC_BATCH, c_win, C_KV_HEADS, HEAD_DIM), 1.0),
        'cache_c_v': nrm(ks[5], (DEPTH, DEC_BATCH, c_win, C_KV_HEADS, HEAD_DIM), 1.0),
        'state_b_wkv': nrm(ks[6], (DEPTH, DEC_BATCH, B_HEADS, HEAD_DIM, HEAD_DIM), 0.3),
        'state_b_shift': nrm(ks[7], (DEPTH, DEC_BATCH, B_COLS), 1.0),
        'g_mix': 1.0 + nrm(ks[8], (DEPTH, D_MODEL), 0.02),
        'w_in': nrm(ks[9], (DEPTH, D_MODEL, IN_COLS), D_MODEL ** -0.5),
        'w_out': nrm(ks[10], (DEPTH, MIX_DIM, D_MODEL), 0.5 * MIX_DIM ** -0.5),
        'b_mu': jax.random.uniform(ks[11], (DEPTH, B_COLS), f32, 0.0, 1.0),
        'b_w0': jax.random.uniform(ks[12], (DEPTH, B_DIM), f32, -6.0, -1.0),
        'b_w2': nrm(ks[13], (DEPTH, B_DECAY_LORA, B_DIM), 0.1),
        'b_a0': nrm(ks[14], (DEPTH, B_DIM), 0.1),
        'b_a2': nrm(ks[15], (DEPTH, B_AAA_LORA, B_DIM), 0.1),
        'b_g2': nrm(ks[16], (DEPTH, B_GATE_LORA, B_DIM), B_GATE_LORA ** -0.5),
        'b_k_k': 0.85 + nrm(ks[17], (DEPTH, B_DIM), 0.05),
        'b_k_a': 1.0 + nrm(ks[18], (DEPTH, B_DIM), 0.05),
        'b_r_k': nrm(ks[19], (DEPTH, B_DIM), 0.1),
        'b_lnx_w': 1.0 + nrm(ks[20], (DEPTH, B_DIM), 0.02),
        'b_lnx_b': nrm(ks[21], (DEPTH, B_DIM), 0.02),
        'c_sink': nrm(ks[22], (DEPTH, C_KV_HEADS, C_GROUP), 1.0),
        'g_ffn': 1.0 + nrm(ks[23], (DEPTH, D_MODEL), 0.02),
        'w_gate': nrm(ks[24], (DEPTH, D_MODEL, D_FF), D_MODEL ** -0.5),
        'w_up': nrm(ks[25], (DEPTH, D_MODEL, D_FF), D_MODEL ** -0.5),
        'w_down': nrm(ks[26], (DEPTH, D_FF, D_MODEL), 0.5 * D_FF ** -0.5),
        'g_final': 1.0 + nrm(ks[27], (D_MODEL,), 0.02),
    }


def reference(x_prompt, x_sample, cache_a_k, cache_a_v, cache_c_k, cache_c_v, state_b_wkv, state_b_shift,
              g_mix, w_in, w_out, b_mu, b_w0, b_w2, b_a0, b_a2, b_g2, b_k_k, b_k_a, b_r_k, b_lnx_w, b_lnx_b,
              c_sink, g_ffn, w_gate, w_up, w_down, g_final):
    pos_p = jnp.arange(x_prompt.shape[1], dtype=jnp.int32)
    pos_s = PAST_LEN + jnp.arange(x_sample.shape[1], dtype=jnp.int32)
    hp, hs = x_prompt, x_sample
    new_p = [[] for _ in range(6)]
    new_s = [[] for _ in range(6)]
    for l in range(DEPTH):
        lw = (g_mix[l], w_in[l], w_out[l], b_mu[l], b_w0[l], b_w2[l], b_a0[l], b_a2[l], b_g2[l],
              b_k_k[l], b_k_a[l], b_r_k[l], b_lnx_w[l], b_lnx_b[l], c_sink[l], g_ffn[l],
              w_gate[l], w_up[l], w_down[l])
        hp, st_p = trunk_layer(hp, pos_p, lw, None)
        hs, st_s = trunk_layer(hs, pos_s, lw, (cache_a_k[l], cache_a_v[l], cache_c_k[l], cache_c_v[l],
                                               state_b_wkv[l], state_b_shift[l]))
        for i in range(6):
            new_p[i].append(st_p[i])
            new_s[i].append(st_s[i])
    y_prompt = rms_norm(hp, g_final)
    y_sample = rms_norm(hs, g_final)
    a_k_p, a_v_p, c_k_p, c_v_p, wkv_p, shift_p = [jnp.stack(t, axis=0) for t in new_p]
    a_k_s, a_v_s, c_k_s, c_v_s, wkv_s, shift_s = [jnp.stack(t, axis=0) for t in new_s]
    return (y_prompt, y_sample, a_k_p, a_v_p, c_k_p, c_v_p, wkv_p, shift_p,
            a_k_s, a_v_s, c_k_s, c_v_s, wkv_s, shift_s)
```

```cpp
#include <hip/hip_runtime.h>
#include <cstdio>
#include <cstdint>

constexpr int DM = 2048, SEQ = 2048, NBATCH = 4, MP = NBATCH * SEQ, DECB = 32, DECS = 8, MS = DECB * DECS, MTOT = MP + MS;
constexpr int DEPTH = 4, BCOLS = 1792, INC = 4608, FF = 5632, NGU = 2 * FF;
constexpr int PASTLEN = 16384;
constexpr float RMS_EPS = 1e-6f, GN_EPS = 64e-5f;
constexpr float QSCALE = 0.125f * 1.4426950408889634f;
constexpr float LN2F = 0.6931471805599453f;
namespace pg8 {
#define PG8_LAS __attribute__((address_space(3)))
typedef unsigned short bf16_t;
typedef short bf16x8 __attribute__((ext_vector_type(8)));
typedef float f32x4 __attribute__((ext_vector_type(4)));
typedef unsigned u32x4 __attribute__((ext_vector_type(4)));
constexpr int BM = 256, BK = 64, HALF = 128, HTB = HALF * BK * 2  , STAGE_BYTES = 8 * HTB, NXCD = 8, WGM = 8;

__host__ __device__ __forceinline__ int lds_byte(int r, int c) { const int st = (r >> 4) * 2 + (c >> 5), rr = r & 15, cc = c & 31, ob = rr * 64 + cc * 2; return st * 1024 + (ob ^ (((ob >> 9) & 1) << 5)); }
__host__ __device__ __forceinline__ void stage_rc(int b, int& R, int& C) { const int st = b / 1024, sb = b % 1024, swz = sb ^ (((sb >> 9) & 1) << 5); R = (st >> 1) * 16 + swz / 64; C = (st & 1) * 32 + (swz % 64) / 2; }
__host__ __device__ __forceinline__ int perm32(int rho) { const int n = rho >> 4, i = rho & 15; return 8 * (i >> 2) + 4 * n + (i & 3); }

struct Unit { int pm, pn; };
struct Gemm { const bf16_t* A; const bf16_t* Bt; int M, N, K, ld; };

struct StaticOrder {
    int nM, nN, nwg, G, c;
    __host__ __device__ void init(int M, int N, int G_, int c_) { nM = M / BM; nN = N / BM; nwg = nM * nN; G = G_; c = c_; }
    __host__ __device__ bool unit_at(long L, Unit& u) const {
        if (L >= nwg) return false;
        int wgid = (int)L; { const int q = nwg / NXCD, r = nwg % NXCD, xcd = wgid % NXCD, off = wgid / NXCD; wgid = (xcd < r ? xcd * (q + 1) : r * (q + 1) + (xcd - r) * q) + off; }
        const int nig = WGM * nN, gid = wgid / nig, fm = gid * WGM, gsz = (nM - fm) < WGM ? (nM - fm) : WGM;
        u.pm = fm + ((wgid % nig) % gsz); u.pn = (wgid % nig) / gsz; return true;
    }
    __host__ __device__ bool next(int i, Unit& u) const { return unit_at((long)i * G + c, u); }
    __device__ __forceinline__ void a_ready(const Unit&) const {}
    __device__ __forceinline__ void done(const Unit&) const {}
};


struct GuOrder {
    StaticOrder so; int c;
    static constexpr int MP_ROWS = 8192, SPEC0 = 234;
    __host__ __device__ void init(int G_, int c_) { so.init(MP_ROWS, 2 * 5632, G_, c_); c = c_; }
    __host__ __device__ bool next(int i, Unit& u) const {
        if (c >= SPEC0) { const int k = c - SPEC0;
            if (i < 2) return so.unit_at((long)i * 256 + c, u);
            if (i < 4) { u.pm = MP_ROWS / 256; u.pn = 2 * k + (i - 2); return true; }
            return false; }
        const int np = c < 128 ? 6 : 5;
        if (i < np) return so.unit_at((long)i * 256 + c, u);
        if (i == 5 && c < 194) { const int j = c - 128; return so.unit_at(512 + 256 * (j / 22) + SPEC0 + (j % 22), u); }
        return false;
    }
    __device__ __forceinline__ void a_ready(const Unit&) const {}
    __device__ __forceinline__ void done(const Unit&) const {}
};
struct RowUnits {
    int nt; bool have;
    __host__ __device__ bool next(int i, Unit& u) const { if (!have || i >= nt) return false; u.pm = 0; u.pn = i; return true; }
    __device__ __forceinline__ void a_ready(const Unit&) const {}
    __device__ __forceinline__ void done(const Unit&) const {}
};
struct OneUnit {
    int pm = 0, pn; bool have;
    __host__ __device__ bool next(int i, Unit& u) const { if (i != 0 || !have) return false; u.pm = pm; u.pn = pn; return true; }
    __device__ __forceinline__ void a_ready(const Unit&) const {}
    __device__ __forceinline__ void done(const Unit&) const {}
};
__device__ __forceinline__ unsigned cvt_pk_bf16(float lo, float hi) { unsigned r; asm volatile("v_cvt_pk_bf16_f32 %0, %1, %2" : "=v"(r) : "v"(lo), "v"(hi)); return r; }
__device__ __forceinline__ void st_bf16x8(bf16_t* p, const f32x4 a, const f32x4 b) { u32x4 w; w.x = cvt_pk_bf16(a[0], a[1]); w.y = cvt_pk_bf16(a[2], a[3]); w.z = cvt_pk_bf16(b[0], b[1]); w.w = cvt_pk_bf16(b[2], b[3]); *(u32x4*)p = w; }
__device__ __forceinline__ void st_f32x8(float* p, const f32x4 a, const f32x4 b) { *(f32x4*)p = a; *(f32x4*)(p + 4) = b; }

struct EpiIn {
    static constexpr bool PERM = true, AFTER_DRAIN = false;
    const float* ssq; const float* rope;
    bf16_t *QA, *KA, *VA, *QC, *KC, *VC; float* PB;
    float *o_ak_p, *o_av_p, *o_ck_p, *o_cv_p, *o_sh_p, *o_ak_s, *o_av_s, *o_ck_s, *o_cv_s, *o_sh_s;
    template <int TY> __device__ __forceinline__ void run(const f32x4 (&acc)[2][2][4][2], const Unit& u, int wr, int wc, int fr, int fq) const {
        const int pn = u.pn; const bool isS = (u.pm == MP / 256);
        const int cl = wc * 32 + fq * 8;
        float rs[2][4];
#pragma unroll
        for (int ai = 0; ai < 2; ++ai)
#pragma unroll
            for (int m = 0; m < 4; ++m) rs[ai][m] = ssq[u.pm * 256 + ai * 128 + wr * 64 + m * 16 + fr];
#pragma unroll
        for (int ai = 0; ai < 2; ++ai)
#pragma unroll
            for (int m = 0; m < 4; ++m) {
                const int row = u.pm * 256 + ai * 128 + wr * 64 + m * 16 + fr;
                const float rstd = rsqrtf(rs[ai][m] * (1.0f / DM) + RMS_EPS);
                int b, t, pidx;
                if (!isS) { b = row >> 11; t = row & 2047; pidx = t; } else { const int r = row - MP; b = r >> 3; t = r & 7; pidx = SEQ + t; }
#pragma unroll
                for (int bj = 0; bj < 2; ++bj) {
                    f32x4 v0 = acc[ai][bj][m][0] * rstd, v1 = acc[ai][bj][m][1] * rstd;
                    const int c = bj * 128 + cl;
                    const bool roped = (TY == 0 || TY == 1 || TY == 4 || (TY == 5 && bj == 0));
                    if (roped && (wc & 1) == 0) {
                        f32x4 p0, p1;
#pragma unroll
                        for (int j = 0; j < 4; ++j) { p0[j] = __shfl_xor(v0[j], 16); p1[j] = __shfl_xor(v1[j], 16); }
                        const float* rp = rope + pidx * 16;
                        const f32x4 c0 = *(const f32x4*)rp, c1 = *(const f32x4*)(rp + 4), s0 = *(const f32x4*)(rp + 8), s1 = *(const f32x4*)(rp + 12);
                        if (fq == 0) { v0 = v0 * c0 - p0 * s0; v1 = v1 * c1 - p1 * s1; }
                        else if (fq == 1) { v0 = v0 * c0 + p0 * s0; v1 = v1 * c1 + p1 * s1; }
                    }
                    if (TY == 0) { st_bf16x8(QA + (size_t)row * 512 + pn * 256 + c, v0 * QSCALE, v1 * QSCALE); }
                    if (TY == 1) { st_bf16x8(KA + (size_t)row * 512 + (pn - 2) * 256 + c, v0, v1);
                        float* o = (isS ? o_ak_s + (size_t)(row - MP) * 512 : o_ak_p + (size_t)row * 512) + (pn - 2) * 256 + c; st_f32x8(o, v0, v1); }
                    if (TY == 2) { st_bf16x8(VA + (size_t)row * 512 + (pn - 4) * 256 + c, v0, v1);
                        float* o = (isS ? o_av_s + (size_t)(row - MP) * 512 : o_av_p + (size_t)row * 512) + (pn - 4) * 256 + c; st_f32x8(o, v0, v1); }
                    if (TY == 3) { const int cc = (pn - 6) * 256 + c; st_f32x8(PB + (size_t)row * BCOLS + cc, v0, v1);
                        if (!isS && t == SEQ - 1) st_f32x8(o_sh_p + b * BCOLS + cc, v0, v1);
                        if (isS && t == DECS - 1) st_f32x8(o_sh_s + b * BCOLS + cc, v0, v1); }
                    if (TY == 4) { st_bf16x8(QC + (size_t)row * 1024 + (pn - 13) * 256 + c, v0 * QSCALE, v1 * QSCALE); }
                    if (TY == 5) {
                        bf16_t* dst = (bj == 0 ? KC : VC) + (size_t)row * 128 + cl; st_bf16x8(dst, v0, v1);
                        float* op = bj == 0 ? o_ck_p : o_cv_p; float* os = bj == 0 ? o_ck_s : o_cv_s;
                        if (isS) st_f32x8(os + (size_t)(row - MP) * 128 + cl, v0, v1);
                        else if (t >= SEQ - 128) st_f32x8(op + (size_t)(b * 128 + t - (SEQ - 128)) * 128 + cl, v0, v1);
                    }
                }
                asm volatile("" ::: "memory");
            }
    }
    __device__ __forceinline__ void operator()(const f32x4 (&acc)[2][2][4][2], const Unit& u, int wr, int wc, int fr, int fq) const {
        asm volatile("" : "+v"(fr), "+v"(fq));
        const int pn = u.pn;
        if (pn < 2) run<0>(acc, u, wr, wc, fr, fq);
        else if (pn < 4) run<1>(acc, u, wr, wc, fr, fq);
        else if (pn < 6) run<2>(acc, u, wr, wc, fr, fq);
        else if (pn < 13) run<3>(acc, u, wr, wc, fr, fq);
        else if (pn < 17) run<4>(acc, u, wr, wc, fr, fq);
        else run<5>(acc, u, wr, wc, fr, fq);
        asm volatile("s_waitcnt vmcnt(0)" ::: "memory");
    }
};
struct EpiRes {
    static constexpr bool PERM = true, AFTER_DRAIN = false;
    float* X; const float* Xin; bf16_t* XN; float* ssq_next; int dry;
    __device__ __forceinline__ void operator()(const f32x4 (&acc)[2][2][4][2], const Unit& u, int wr, int wc, int fr, int fq) const {
        asm volatile("" : "+v"(fr), "+v"(fq));
        const int cl = u.pn * 256 + wc * 32 + fq * 8;
        f32x4 xc[2][2], xn[2][2];
        { const float* xp = Xin + (size_t)(u.pm * 256 + wr * 64 + fr) * DM + cl;
          xc[0][0] = *(const f32x4*)xp; xc[0][1] = *(const f32x4*)(xp + 4); xc[1][0] = *(const f32x4*)(xp + 128); xc[1][1] = *(const f32x4*)(xp + 132); }
        xn[0][0] = xn[0][1] = xn[1][0] = xn[1][1] = (f32x4){0.f, 0.f, 0.f, 0.f};
#pragma unroll
        for (int ai = 0; ai < 2; ++ai)
#pragma unroll
            for (int m = 0; m < 4; ++m) {
                const int row = u.pm * 256 + ai * 128 + wr * 64 + m * 16 + fr; float s = 0.f;
                if (!(ai == 1 && m == 3)) { const int g1 = ai * 4 + m + 1; const float* xp = Xin + (size_t)(u.pm * 256 + (g1 >> 2) * 128 + wr * 64 + (g1 & 3) * 16 + fr) * DM + cl;
                    xn[0][0] = *(const f32x4*)xp; xn[0][1] = *(const f32x4*)(xp + 4); xn[1][0] = *(const f32x4*)(xp + 128); xn[1][1] = *(const f32x4*)(xp + 132); }
#pragma unroll
                for (int bj = 0; bj < 2; ++bj) {
                    float* xp = X + (size_t)row * DM + cl + bj * 128;
                    const f32x4 x0 = xc[bj][0] + acc[ai][bj][m][0], x1 = xc[bj][1] + acc[ai][bj][m][1];
                    if (!dry) { st_f32x8(xp, x0, x1); st_bf16x8(XN + (size_t)row * DM + cl + bj * 128, x0, x1); }
                    s += (x0[0] * x0[0] + x0[1] * x0[1]) + (x0[2] * x0[2] + x0[3] * x0[3]) + (x1[0] * x1[0] + x1[1] * x1[1]) + (x1[2] * x1[2] + x1[3] * x1[3]);
                }
                s += __shfl_xor(s, 16); s += __shfl_xor(s, 32);
                if (fq == 0 && !dry) unsafeAtomicAdd(ssq_next + row, s);
                asm volatile("" ::: "memory");
                xc[0][0] = xn[0][0]; xc[0][1] = xn[0][1]; xc[1][0] = xn[1][0]; xc[1][1] = xn[1][1];
            }
    }
};
struct EpiFinal {
    static constexpr bool PERM = true, AFTER_DRAIN = true;
    const float* X; float* OUT; const float* gf; float* ssq; unsigned* cnt;
    __device__ __forceinline__ void fused(const f32x4 (&acc)[2][2][4][2], const Unit& u, int wr, int wc, int fr, int fq, PG8_LAS unsigned char*, int wid, int lane) const {
        asm volatile("" : "+v"(fr), "+v"(fq));
        const int cl = u.pn * 256 + wc * 32 + fq * 8;
        f32x4 xv[2][4][2][2];
        f32x4 xc[2][2], xn[2][2];
        { const float* xp = X + (size_t)(u.pm * 256 + wr * 64 + fr) * DM + cl;
          xc[0][0] = *(const f32x4*)xp; xc[0][1] = *(const f32x4*)(xp + 4); xc[1][0] = *(const f32x4*)(xp + 128); xc[1][1] = *(const f32x4*)(xp + 132); }
        xn[0][0] = xn[0][1] = xn[1][0] = xn[1][1] = (f32x4){0.f, 0.f, 0.f, 0.f};
#pragma unroll
        for (int ai = 0; ai < 2; ++ai)
#pragma unroll
            for (int m = 0; m < 4; ++m) {
                const int row = u.pm * 256 + ai * 128 + wr * 64 + m * 16 + fr; float s = 0.f;
                if (!(ai == 1 && m == 3)) { const int g1 = ai * 4 + m + 1; const float* xp = X + (size_t)(u.pm * 256 + (g1 >> 2) * 128 + wr * 64 + (g1 & 3) * 16 + fr) * DM + cl;
                    xn[0][0] = *(const f32x4*)xp; xn[0][1] = *(const f32x4*)(xp + 4); xn[1][0] = *(const f32x4*)(xp + 128); xn[1][1] = *(const f32x4*)(xp + 132); }
#pragma unroll
                for (int bj = 0; bj < 2; ++bj) {
                    const f32x4 x0 = xc[bj][0] + acc[ai][bj][m][0], x1 = xc[bj][1] + acc[ai][bj][m][1];
                    xv[ai][m][bj][0] = x0; xv[ai][m][bj][1] = x1;
                    s += (x0[0] * x0[0] + x0[1] * x0[1]) + (x0[2] * x0[2] + x0[3] * x0[3]) + (x1[0] * x1[0] + x1[1] * x1[1]) + (x1[2] * x1[2] + x1[3] * x1[3]);
                }
                s += __shfl_xor(s, 16); s += __shfl_xor(s, 32);
                if (fq == 0) (void)__hip_atomic_fetch_add(ssq + row, s, __ATOMIC_RELAXED, __HIP_MEMORY_SCOPE_AGENT);
                asm volatile("" ::: "memory");
                xc[0][0] = xn[0][0]; xc[0][1] = xn[0][1]; xc[1][0] = xn[1][0]; xc[1][1] = xn[1][1];
            }
        asm volatile("s_waitcnt vmcnt(0)" ::: "memory");
        __syncthreads();
        if (wid == 0 && lane == 0) {
            unsigned long long ci_ = (unsigned long long)(cnt + u.pm * 32); asm volatile("" : "+v"(ci_)); unsigned* cp = (unsigned*)(__attribute__((address_space(1))) unsigned*)ci_;
            (void)__hip_atomic_fetch_add(cp, 1u, __ATOMIC_RELAXED, __HIP_MEMORY_SCOPE_AGENT);
            unsigned sp = 0; while (__hip_atomic_load(cp, __ATOMIC_RELAXED, __HIP_MEMORY_SCOPE_AGENT) < 8u) { __builtin_amdgcn_s_sleep(1); if (++sp > (1u << 22)) break; }
        }
        __syncthreads();
        float rs[2][4];
#pragma unroll
        for (int ai = 0; ai < 2; ++ai)
#pragma unroll
            for (int m = 0; m < 4; ++m) rs[ai][m] = __hip_atomic_load(ssq + u.pm * 256 + ai * 128 + wr * 64 + m * 16 + fr, __ATOMIC_RELAXED, __HIP_MEMORY_SCOPE_AGENT);
        f32x4 gg[2][2];
#pragma unroll
        for (int bj = 0; bj < 2; ++bj) { gg[bj][0] = *(const f32x4*)(gf + cl + bj * 128); gg[bj][1] = *(const f32x4*)(gf + cl + bj * 128 + 4); }
#pragma unroll
        for (int ai = 0; ai < 2; ++ai)
#pragma unroll
            for (int m = 0; m < 4; ++m) {
                const int row = u.pm * 256 + ai * 128 + wr * 64 + m * 16 + fr;
                const float rstd = rsqrtf(rs[ai][m] * (1.0f / DM) + RMS_EPS);
#pragma unroll
                for (int bj = 0; bj < 2; ++bj) st_f32x8(OUT + (size_t)row * DM + cl + bj * 128, xv[ai][m][bj][0] * rstd * gg[bj][0], xv[ai][m][bj][1] * rstd * gg[bj][1]);
                asm volatile("" ::: "memory");
            }
    }
};
struct EpiPart {
    static constexpr bool PERM = true, AFTER_DRAIN = false;
    float* P;
    __device__ __forceinline__ void operator()(const f32x4 (&acc)[2][2][4][2], const Unit& u, int wr, int wc, int fr, int fq) const {
        asm volatile("" : "+v"(fr), "+v"(fq));
        const int cl = u.pn * 256 + wc * 32 + fq * 8;
#pragma unroll
        for (int ai = 0; ai < 2; ++ai)
#pragma unroll
            for (int m = 0; m < 4; ++m) {
                const int row = ai * 128 + wr * 64 + m * 16 + fr;
#pragma unroll
                for (int bj = 0; bj < 2; ++bj) st_f32x8(P + (size_t)row * DM + cl + bj * 128, acc[ai][bj][m][0], acc[ai][bj][m][1]);
            }
    }
};
struct EpiGU {
    static constexpr bool PERM = true, AFTER_DRAIN = false;
    const float* ssq; bf16_t* ACT;
    __device__ __forceinline__ void operator()(const f32x4 (&acc)[2][2][4][2], const Unit& u, int wr, int wc, int fr, int fq) const {
        asm volatile("" : "+v"(fr), "+v"(fq));
        const int cl = u.pn * 128 + wc * 32 + fq * 8;
        float rs[2][4];
#pragma unroll
        for (int ai = 0; ai < 2; ++ai)
#pragma unroll
            for (int m = 0; m < 4; ++m) rs[ai][m] = ssq[u.pm * 256 + ai * 128 + wr * 64 + m * 16 + fr];
#pragma unroll
        for (int ai = 0; ai < 2; ++ai)
#pragma unroll
            for (int m = 0; m < 4; ++m) {
                const int row = u.pm * 256 + ai * 128 + wr * 64 + m * 16 + fr;
                const float rstd = rsqrtf(rs[ai][m] * (1.0f / DM) + RMS_EPS);
                f32x4 o[2];
#pragma unroll
                for (int n = 0; n < 2; ++n) {
                    const f32x4 g = acc[ai][0][m][n] * rstd, up = acc[ai][1][m][n] * rstd;
#pragma unroll
                    for (int j = 0; j < 4; ++j) o[n][j] = g[j] * __builtin_amdgcn_rcpf(1.0f + __builtin_amdgcn_exp2f(-1.4426950408889634f * g[j])) * up[j];
                }
                st_bf16x8(ACT + (size_t)row * FF + cl, o[0], o[1]);
                asm volatile("" ::: "memory");
            }
    }
};

template <class Epi, class Sched, bool ALIGN_EPI = false, bool SP2 = false>
__device__ __forceinline__ void gemm_phase(PG8_LAS unsigned char* lds, const Gemm g, const Sched& S, const Epi& E, const int wave_id) {
    int lane_; asm volatile("v_mbcnt_lo_u32_b32 %0, -1, 0\n\tv_mbcnt_hi_u32_b32 %0, -1, %0" : "=v"(lane_));
    const int wid = wave_id, lane = lane_, tid = wid * 64 + lane, wr = wid >> 2, wc = wid & 3, fr = lane & 15, fq = lane >> 4;
    const int K = g.K, nt = K / BK;
    unsigned voffA[2], voffB[2];
#pragma unroll
    for (int i = 0; i < 2; ++i) { int R, C; stage_rc(tid * 16 + i * 8192, R, C); const int Rb = Epi::PERM ? ((R & ~31) + perm32(R & 31)) : R;
        voffA[i] = (unsigned)(R * g.ld + C) * 2u; voffB[i] = (unsigned)(Rb * g.ld + C) * 2u; }
    const size_t kstep = (size_t)(BK * 2);
    const size_t hstep = (size_t)HALF * g.ld * 2;
    const size_t tstep = 2 * hstep;
    const unsigned ldsw = (unsigned)wid * 1024u;
    const int aoff = lds_byte(wr * 64 + fr, fq * 8), boff = lds_byte(wc * 32 + fr, fq * 8);
#define PG8_SA(b, h) (((b) * 2 + (h)) * HTB)
#define PG8_SB(b, h) ((4 + (b) * 2 + (h)) * HTB)
#define PG8_STAGE(bufoff, gbase, voff) do { _Pragma("unroll") for (int _i = 0; _i < 2; ++_i) \
        __builtin_amdgcn_global_load_lds((const unsigned*)((const char*)(gbase) + (voff)[_i]), (PG8_LAS unsigned*)(lds + (bufoff) + ldsw + _i * 8192), 16, 0, 0); } while (0)
#define PG8_LDA(dst, b, h) do { _Pragma("unroll") for (int m = 0; m < 4; ++m) _Pragma("unroll") for (int k = 0; k < 2; ++k) dst[m][k] = *(const PG8_LAS bf16x8*)(lds + PG8_SA(b, h) + aoff + m * 2048 + k * 1024); } while (0)
#define PG8_LDB(dst, b, h) do { _Pragma("unroll") for (int n = 0; n < 2; ++n) _Pragma("unroll") for (int k = 0; k < 2; ++k) dst[n][k] = *(const PG8_LAS bf16x8*)(lds + PG8_SB(b, h) + boff + n * 2048 + k * 1024); } while (0)
#define PG8_MMA(ai, bj, At, Bt) do { __builtin_amdgcn_s_setprio(1); _Pragma("unroll") for (int m = 0; m < 4; ++m) _Pragma("unroll") for (int n = 0; n < 2; ++n) _Pragma("unroll") for (int k = 0; k < 2; ++k) \
        acc[ai][bj][m][n] = __builtin_amdgcn_mfma_f32_16x16x32_bf16(Bt[n][k], At[m][k], acc[ai][bj][m][n], 0, 0, 0); __builtin_amdgcn_s_setprio(0); } while (0)
#define PG8_WAIT_V(n) asm volatile("s_waitcnt vmcnt(" #n ")" ::: "memory")
#define PG8_WAIT_L(n) asm volatile("s_waitcnt lgkmcnt(" #n ")" ::: "memory")
#define PG8_BAR __builtin_amdgcn_s_barrier()
#define PG8_SCHED __builtin_amdgcn_sched_barrier(0)
    Unit cur, nxt; int ui = 0;
    if (!S.next(0, cur)) return;
    f32x4 acc[2][2][4][2];
#pragma unroll
    for (int a = 0; a < 2; ++a)
#pragma unroll
        for (int b = 0; b < 2; ++b)
#pragma unroll
            for (int m = 0; m < 4; ++m)
#pragma unroll
                for (int n = 0; n < 2; ++n) acc[a][b][m][n] = (f32x4){0.f, 0.f, 0.f, 0.f};
    bf16x8 At[4][2], B0[2][2], B1[2][2];
    const char* cA = (const char*)g.A + (size_t)cur.pm * tstep; const char* cB = (const char*)g.Bt + (size_t)cur.pn * tstep;
    S.a_ready(cur);
    if constexpr (SP2) {
        PG8_STAGE(PG8_SB(0, 0), cB, voffB); PG8_STAGE(PG8_SB(0, 1), cB + hstep, voffB); PG8_STAGE(PG8_SA(0, 0), cA, voffA); PG8_STAGE(PG8_SA(0, 1), cA + hstep, voffA);
        if (wr == 1) PG8_BAR;
        PG8_WAIT_V(2); PG8_BAR;
        PG8_STAGE(PG8_SB(1, 0), cB + kstep, voffB); PG8_STAGE(PG8_SA(1, 0), cA + kstep, voffA); PG8_STAGE(PG8_SB(1, 1), cB + hstep + kstep, voffB);
        PG8_WAIT_V(6); PG8_BAR;
    } else {
        PG8_STAGE(PG8_SB(0, 0), cB, voffB); PG8_STAGE(PG8_SA(0, 0), cA, voffA); PG8_STAGE(PG8_SB(0, 1), cB + hstep, voffB); PG8_STAGE(PG8_SA(0, 1), cA + hstep, voffA);
        if (wr == 1) PG8_BAR;
        PG8_WAIT_V(4); PG8_BAR;
        PG8_STAGE(PG8_SB(1, 0), cB + kstep, voffB); PG8_STAGE(PG8_SA(1, 0), cA + kstep, voffA); PG8_STAGE(PG8_SB(1, 1), cB + hstep + kstep, voffB);
        PG8_WAIT_V(6); PG8_BAR;
    }
    for (;;) {
        const bool has_next = S.next(ui + 1, nxt);
        const char* nA = has_next ? (const char*)g.A + (size_t)nxt.pm * tstep : cA; const char* nB = has_next ? (const char*)g.Bt + (size_t)nxt.pn * tstep : cB;
        for (int t = 0; t < nt; t += 2) {
            const bool last = (t == nt - 2);
            const char* a1 = cA + (size_t)(t + 1) * kstep;
            const char* a2 = last ? nA : cA + (size_t)(t + 2) * kstep; const char* b2 = last ? nB : cB + (size_t)(t + 2) * kstep;
            const char* a3 = a2 + kstep; const char* b3 = b2 + kstep;
            if (last && has_next) S.a_ready(nxt);
            if constexpr (SP2) {
            PG8_LDB(B0, 0, 0); PG8_LDB(B1, 0, 1); PG8_SCHED; PG8_LDA(At, 0, 0); PG8_STAGE(PG8_SA(1, 1), a1 + hstep, voffA);
            PG8_WAIT_V(8); PG8_WAIT_L(0); PG8_BAR; PG8_MMA(0, 0, At, B0); PG8_MMA(0, 1, At, B1); PG8_BAR; PG8_SCHED;
            PG8_LDA(At, 0, 1); PG8_STAGE(PG8_SB(0, 0), b2, voffB); PG8_STAGE(PG8_SB(0, 1), b2 + hstep, voffB); PG8_STAGE(PG8_SA(0, 0), a2, voffA);
            PG8_WAIT_V(8); PG8_WAIT_L(0); PG8_BAR; PG8_MMA(1, 0, At, B0); PG8_MMA(1, 1, At, B1); PG8_BAR; PG8_SCHED;
            PG8_LDB(B0, 1, 0); PG8_LDB(B1, 1, 1); PG8_SCHED; PG8_LDA(At, 1, 0); PG8_STAGE(PG8_SA(0, 1), a2 + hstep, voffA);
            PG8_WAIT_V(8); PG8_WAIT_L(0); PG8_BAR; PG8_MMA(0, 0, At, B0); PG8_MMA(0, 1, At, B1); PG8_BAR; PG8_SCHED;
            PG8_LDA(At, 1, 1); PG8_STAGE(PG8_SB(1, 0), b3, voffB); PG8_STAGE(PG8_SB(1, 1), b3 + hstep, voffB); PG8_STAGE(PG8_SA(1, 0), a3, voffA);
            PG8_WAIT_V(8); PG8_WAIT_L(0); PG8_BAR; PG8_MMA(1, 0, At, B0); PG8_MMA(1, 1, At, B1); PG8_BAR; PG8_SCHED;
            } else {
            PG8_LDB(B0, 0, 0); PG8_SCHED; PG8_LDA(At, 0, 0); PG8_STAGE(PG8_SA(1, 1), a1 + hstep, voffA);
            PG8_WAIT_L(8); PG8_BAR; PG8_WAIT_L(0); PG8_MMA(0, 0, At, B0); PG8_BAR; PG8_SCHED;
            PG8_LDB(B1, 0, 1); PG8_STAGE(PG8_SB(0, 0), b2, voffB);
            PG8_BAR; PG8_WAIT_L(0); PG8_MMA(0, 1, At, B1); PG8_BAR;
            PG8_LDA(At, 0, 1); PG8_STAGE(PG8_SA(0, 0), a2, voffA);
            PG8_BAR; PG8_WAIT_L(0); PG8_MMA(1, 0, At, B0); PG8_BAR; PG8_SCHED;
            PG8_STAGE(PG8_SB(0, 1), b2 + hstep, voffB);
            PG8_WAIT_V(6); PG8_BAR; PG8_MMA(1, 1, At, B1); PG8_BAR;
            PG8_LDB(B0, 1, 0); PG8_SCHED; PG8_LDA(At, 1, 0); PG8_STAGE(PG8_SA(0, 1), a2 + hstep, voffA);
            PG8_WAIT_L(8); PG8_BAR; PG8_WAIT_L(0); PG8_MMA(0, 0, At, B0); PG8_BAR; PG8_SCHED;
            PG8_LDB(B1, 1, 1); PG8_STAGE(PG8_SB(1, 0), b3, voffB);
            PG8_BAR; PG8_WAIT_L(0); PG8_MMA(0, 1, At, B1); PG8_BAR;
            PG8_LDA(At, 1, 1); PG8_STAGE(PG8_SA(1, 0), a3, voffA);
            PG8_BAR; PG8_WAIT_L(0); PG8_MMA(1, 0, At, B0); PG8_BAR; PG8_SCHED;
            PG8_STAGE(PG8_SB(1, 1), b3 + hstep, voffB);
            PG8_WAIT_V(6); PG8_BAR; PG8_MMA(1, 1, At, B1); PG8_BAR;
            }
        }
        if constexpr (ALIGN_EPI) { if (wr == 0) PG8_BAR; }
        if constexpr (!Epi::AFTER_DRAIN) { E(acc, cur, wr, wc, fr, fq); S.done(cur); }
        if (!has_next) break;
#pragma unroll
        for (int a = 0; a < 2; ++a)
#pragma unroll
            for (int b = 0; b < 2; ++b)
#pragma unroll
                for (int m = 0; m < 4; ++m)
#pragma unroll
                    for (int n = 0; n < 2; ++n) acc[a][b][m][n] = (f32x4){0.f, 0.f, 0.f, 0.f};
        cur = nxt; cA = nA; cB = nB; ++ui;
        if constexpr (ALIGN_EPI) { if (wr == 1) PG8_BAR; }
    }
    PG8_WAIT_V(0);
    if constexpr (!ALIGN_EPI) { if (wr == 0) PG8_BAR; }
    PG8_BAR;
    if constexpr (Epi::AFTER_DRAIN) { E.fused(acc, cur, wr, wc, fr, fq, lds, wid, lane); S.done(cur); }
#undef PG8_SA
#undef PG8_SB
#undef PG8_STAGE
#undef PG8_LDA
#undef PG8_LDB
#undef PG8_MMA
#undef PG8_WAIT_V
#undef PG8_WAIT_L
#undef PG8_BAR
#undef PG8_SCHED
}
}

#define LAS __attribute__((address_space(3)))
typedef unsigned short bf16_t;
typedef unsigned u32x4 __attribute__((ext_vector_type(4)));
typedef unsigned u32x2 __attribute__((ext_vector_type(2)));
typedef float f32x4 __attribute__((ext_vector_type(4)));
typedef float f32x2 __attribute__((ext_vector_type(2)));
typedef short bf16x8 __attribute__((ext_vector_type(8)));
typedef short bf16x4 __attribute__((ext_vector_type(4)));
#define LDS_WAIT() asm volatile("s_waitcnt lgkmcnt(0)" ::: "memory")
__device__ __forceinline__ unsigned f2bf(float f) { unsigned u = __builtin_bit_cast(unsigned, f); return (u + 0x7fffu + ((u >> 16) & 1u)) >> 16; }
__device__ __forceinline__ unsigned pk2(float lo, float hi) { unsigned r; asm("v_cvt_pk_bf16_f32 %0, %1, %2" : "=v"(r) : "v"(lo), "v"(hi)); return r; }
__device__ __forceinline__ float bf2f(unsigned short h) { return __builtin_bit_cast(float, (unsigned)h << 16); }
__device__ __forceinline__ float dppf(float v, const int ctrl) { return v; }
#define DPP_ADD(v, ctrl) ((v) + __builtin_bit_cast(float, __builtin_amdgcn_mov_dpp(__builtin_bit_cast(int, (v)), (ctrl), 0xF, 0xF, true)))
__device__ __forceinline__ float row16_sum(float v) {
    v = DPP_ADD(v, 0xB1);
    v = DPP_ADD(v, 0x4E);
    v = DPP_ADD(v, 0x141);
    v = DPP_ADD(v, 0x140);
    return v;
}
__device__ __forceinline__ float wave_sum(float v) {
    const int iv = __builtin_bit_cast(int, row16_sum(v));
    const float a = __builtin_bit_cast(float, __builtin_amdgcn_readlane(iv, 0)), b = __builtin_bit_cast(float, __builtin_amdgcn_readlane(iv, 16));
    const float c = __builtin_bit_cast(float, __builtin_amdgcn_readlane(iv, 32)), d = __builtin_bit_cast(float, __builtin_amdgcn_readlane(iv, 48));
    return (a + b) + (c + d);
}
__device__ __forceinline__ float sigmoidf_(float x) { return __builtin_amdgcn_rcpf(1.0f + __builtin_amdgcn_exp2f(-1.4426950408889634f * x)); }
__device__ __forceinline__ float tanhf_(float x) { return 1.0f - 2.0f * __builtin_amdgcn_rcpf(1.0f + __builtin_amdgcn_exp2f(2.8853900817779268f * x)); }

#define XB_TMO      128
#define XB_XCNT(j)  (256  + 64 * (j))
#define XB_XSUB(j)  (1280 + 64 * (j))
#define XB_XGEN(j)  (2304 + 64 * (j))
#define XB_TOP      3328
#define XB_TOPGEN   3392
#define XCD_BAR_WORDS 3456
#define XB_SPIN_CAP (1u << 18)

__device__ __forceinline__ unsigned xb_ld(unsigned* p)              { return __hip_atomic_load(p, __ATOMIC_RELAXED, __HIP_MEMORY_SCOPE_AGENT); }
__device__ __forceinline__ unsigned xb_add(unsigned* p, unsigned v) { return __hip_atomic_fetch_add(p, v, __ATOMIC_RELAXED, __HIP_MEMORY_SCOPE_AGENT); }
__device__ __forceinline__ unsigned xb_xcc_id() { return (unsigned)__builtin_amdgcn_s_getreg((3 << 11) | 20) & 0xFu; }
#define XB_SPIN(cond, bar) do { unsigned _sp = 0; while (cond) { __builtin_amdgcn_s_sleep(1); \
    if ((++_sp & 255u) == 0u) { if (xb_ld(&(bar)[XB_TMO])) break; if (_sp > XB_SPIN_CAP) { atomicAdd(&(bar)[XB_TMO], 1u); break; } } } } while (0)

struct XcdBarrier {
    unsigned* bar; unsigned x;
    volatile LAS unsigned* st;
};

__device__ __forceinline__ XcdBarrier xcd_barrier_post(unsigned* bar, volatile LAS unsigned* st) {
    XcdBarrier b; b.bar = bar; b.x = xb_xcc_id(); b.st = st;
    if (threadIdx.x == 0) (void)xb_add(&bar[XB_XCNT(b.x)], 1u);
    return b;
}
__device__ __forceinline__ void xcd_barrier_complete(unsigned* bar, unsigned x, unsigned& nloc, unsigned& nx) {
    const unsigned G = gridDim.x * gridDim.y * gridDim.z;
    unsigned sum, cnt, mine, sp = 0u;
    for (;;) {
        sum = 0u; cnt = 0u; mine = 0u;
#pragma unroll
        for (unsigned j = 0; j < 16; ++j) { const unsigned c = xb_ld(&bar[XB_XCNT(j)]); sum += c; cnt += (c > 0u) ? 1u : 0u; mine = (j == x) ? c : mine; }
        if (sum == G) break;
        __builtin_amdgcn_s_sleep(1);
        if ((++sp & 255u) == 0u) { if (xb_ld(&bar[XB_TMO])) break; if (sp > XB_SPIN_CAP) { atomicAdd(&bar[XB_TMO], 1u); break; } }
    }
    nloc = mine > 0u ? mine : 1u; nx = cnt > 0u ? cnt : 1u;
}

__device__ __forceinline__ void xcd_barrier(const XcdBarrier& b, const bool is_t0) {
    asm volatile("s_waitcnt vmcnt(0)" ::: "memory");
    __syncthreads();
    if (is_t0) {
        unsigned long long bi_ = (unsigned long long)b.bar; asm volatile("" : "+v"(bi_)); unsigned* bar = (unsigned*)(__attribute__((address_space(1))) unsigned*)bi_;
        __builtin_amdgcn_s_waitcnt(0);
        unsigned nloc = b.st[0], nx = b.st[1];
        if (nloc == 0u) { xcd_barrier_complete(bar, b.x, nloc, nx); b.st[0] = nloc; b.st[1] = nx; }
        const unsigned old = xb_add(&bar[XB_XSUB(b.x)], 1u);
        const unsigned gen = old / nloc;
        if (old + 1u == (gen + 1u) * nloc) {
            __builtin_amdgcn_fence(__ATOMIC_RELEASE, "agent");
            asm volatile("s_waitcnt vmcnt(0)" ::: "memory");
            const unsigned og = xb_add(&bar[XB_TOP], 1u);
            const unsigned tg = og / nx;
            if (og + 1u == (tg + 1u) * nx) xb_add(&bar[XB_TOPGEN], 1u);
            else XB_SPIN(xb_ld(&bar[XB_TOPGEN]) == tg, bar);
            __builtin_amdgcn_fence(__ATOMIC_ACQUIRE, "agent");
            xb_add(&bar[XB_XGEN(b.x)], 1u);
            asm volatile("s_waitcnt vmcnt(0)" ::: "memory");
        } else {
            XB_SPIN(xb_ld(&bar[XB_XGEN(b.x)]) == gen, bar);
            __builtin_amdgcn_fence(__ATOMIC_ACQUIRE, "agent");
            asm volatile("s_waitcnt vmcnt(0)" ::: "memory");
        }
    }
    __syncthreads();
}

constexpr size_t MiB = 1u << 20;
constexpr size_t al1(size_t x) { return (x + MiB - 1) / MiB * MiB; }
constexpr size_t WS_CTL = 0, CTL_ZERO_BYTES = 2 * MiB;
constexpr int CW_BAR = 4096, CW_FIN = 16384;
constexpr size_t SSQ_OFF = 256 * 1024;
constexpr size_t WS_ROPE = WS_CTL + CTL_ZERO_BYTES;
constexpr size_t WS_WLT = WS_ROPE + al1(2056 * 16 * 4);
constexpr size_t WS_X = WS_WLT + al1((size_t)DEPTH * 3 * 512 * 96 * 2);
constexpr size_t WS_XN = WS_X + al1((size_t)MTOT * DM * 4);
constexpr size_t WS_QA = WS_XN + al1((size_t)MTOT * DM * 2);
constexpr size_t WS_KA = WS_QA + al1((size_t)MTOT * 512 * 2);
constexpr size_t WS_VA = WS_KA + al1((size_t)MTOT * 512 * 2);
constexpr size_t WS_PB = WS_VA + al1((size_t)MTOT * 512 * 2);
constexpr size_t WS_QC = WS_PB + al1((size_t)MTOT * BCOLS * 4);
constexpr size_t WS_KC = WS_QC + al1((size_t)MTOT * 1024 * 2);
constexpr size_t WS_VC = WS_KC + al1((size_t)MTOT * 128 * 2);
constexpr size_t WS_MIX = WS_VC + al1((size_t)MTOT * 128 * 2);
constexpr size_t WS_ACT = WS_MIX + al1((size_t)MTOT * DM * 2);
constexpr size_t WS_OA = WS_ACT + al1((size_t)MTOT * FF * 2);
constexpr size_t WS_LSE = WS_OA + al1((size_t)3 * MP * 512 * 4);
constexpr int NTH = MP * 8 + MS * 8;
constexpr size_t WS_OPS = WS_LSE + al1((size_t)3 * MP * 8 * 4);
constexpr size_t WS_GG = WS_OPS + al1((size_t)NTH * 6 * 64 * 4);
constexpr size_t WS_BON = WS_GG + al1((size_t)NTH * 64 * 4);
constexpr size_t WS_YZ = WS_BON + al1((size_t)NTH * 4);
constexpr size_t WS_YS = WS_YZ + al1((size_t)MP * 8 * 128 * 4);
constexpr size_t WS_ENDS = WS_YS + al1((size_t)MS * 8 * 64 * 4);
constexpr size_t WS_PART = WS_ENDS + al1((size_t)256 * 2 * 4096 * 4);
constexpr size_t WS_WIN = WS_PART + al1((size_t)22 * MS * DM * 4);
constexpr size_t WS_WOUT = WS_WIN + al1((size_t)DEPTH * INC * DM * 2);
constexpr size_t WS_WGU = WS_WOUT + al1((size_t)DEPTH * DM * DM * 2);
constexpr size_t WS_WDN = WS_WGU + al1((size_t)DEPTH * NGU * DM * 2);
constexpr size_t WS_END = WS_WDN + al1((size_t)DEPTH * DM * FF * 2);

constexpr size_t O_YP = 0, O_YS = O_YP + (size_t)MP * DM, O_AKP = O_YS + (size_t)MS * DM, O_AVP = O_AKP + (size_t)DEPTH * MP * 512, O_CKP = O_AVP + (size_t)DEPTH * MP * 512,
    O_CVP = O_CKP + (size_t)DEPTH * NBATCH * 128 * 128, O_WKVP = O_CVP + (size_t)DEPTH * NBATCH * 128 * 128, O_SHP = O_WKVP + (size_t)DEPTH * NBATCH * 8 * 4096,
    O_AKS = O_SHP + (size_t)DEPTH * NBATCH * BCOLS, O_AVS = O_AKS + (size_t)DEPTH * MS * 512, O_CKS = O_AVS + (size_t)DEPTH * MS * 512, O_CVS = O_CKS + (size_t)DEPTH * MS * 128,
    O_WKVS = O_CVS + (size_t)DEPTH * MS * 128, O_SHS = O_WKVS + (size_t)DEPTH * DECB * 8 * 4096, O_END = O_SHS + (size_t)DEPTH * DECB * BCOLS;

constexpr int RING_BYTES = 139264, MISC_OFF = RING_BYTES + 320, LDS_BYTES = 147456;

constexpr int P0_TS = 136;
__device__ __forceinline__ void p0_item(const float* W, int K, int N, bf16_t* WT, const float* gk, int mode, LAS unsigned char* scr, int item, int lane) {
    const int nblk = N / 64, kb = item / nblk, nb = item % nblk, k0 = 64 * kb, n0 = 64 * nb;
    const int nq = lane & 15, kq = lane >> 4;
    const float* wp = W + (size_t)(k0 + 16 * kq) * N + n0 + 4 * nq;
    f32x4 v[16];
#pragma unroll
    for (int i = 0; i < 16; ++i) v[i] = *(const f32x4*)(wp + (size_t)i * N);
    if (gk) {
        const f32x4 g0 = *(const f32x4*)(gk + k0 + 16 * kq), g1 = *(const f32x4*)(gk + k0 + 16 * kq + 4), g2 = *(const f32x4*)(gk + k0 + 16 * kq + 8), g3 = *(const f32x4*)(gk + k0 + 16 * kq + 12);
#pragma unroll
        for (int i = 0; i < 4; ++i) { v[i] = v[i] * g0[i]; v[4 + i] = v[4 + i] * g1[i]; v[8 + i] = v[8 + i] * g2[i]; v[12 + i] = v[12 + i] * g3[i]; }
    }
#pragma unroll
    for (int j = 0; j < 4; ++j) {
        u32x4 a, b;
        a.x = pk2(v[0][j], v[1][j]); a.y = pk2(v[2][j], v[3][j]); a.z = pk2(v[4][j], v[5][j]); a.w = pk2(v[6][j], v[7][j]);
        b.x = pk2(v[8][j], v[9][j]); b.y = pk2(v[10][j], v[11][j]); b.z = pk2(v[12][j], v[13][j]); b.w = pk2(v[14][j], v[15][j]);
        LAS unsigned char* t = scr + (4 * nq + j) * P0_TS + 32 * kq;
        *(LAS u32x4*)t = a; *(LAS u32x4*)(t + 16) = b;
    }
    LDS_WAIT(); asm volatile("" ::: "memory");
    const int c = lane & 7;
#pragma unroll
    for (int it = 0; it < 8; ++it) {
        const int n = (lane >> 3) + 8 * it;
        const u32x4 o = *(const LAS u32x4*)(scr + n * P0_TS + 16 * c);
        const int nn = n0 + n; const int orow = mode == 0 ? nn : (256 * (nn >> 7) + (nn & 127) + (mode == 2 ? 128 : 0));
        *(u32x4*)(WT + (size_t)orow * K + k0 + 8 * c) = o;
    }
    LDS_WAIT(); asm volatile("" ::: "memory");
}

constexpr int IT_IN = (DM / 64) * (INC / 64), IT_OUT = (DM / 64) * (DM / 64), IT_G = (DM / 64) * (FF / 64), IT_D = (FF / 64) * (DM / 64), IT_A = IT_IN + IT_OUT + IT_D, IT_B = 2 * IT_G;
#define CONV_ITEM_A(ly, r_) do { int r = (r_); \
    if (r < IT_IN) { p0_item(IN(I_WIN) + (size_t)(ly) * DM * INC, DM, INC, G_WIN + (size_t)(ly) * INC * DM, IN(I_GMIX) + (ly) * DM, 0, scr, r, lane); break; } r -= IT_IN; \
    if (r < IT_OUT) { p0_item(IN(I_WOUT) + (size_t)(ly) * DM * DM, DM, DM, G_WOUT + (size_t)(ly) * DM * DM, nullptr, 0, scr, r, lane); break; } r -= IT_OUT; \
    p0_item(IN(I_WD) + (size_t)(ly) * FF * DM, FF, DM, G_WDN + (size_t)(ly) * DM * FF, nullptr, 0, scr, r, lane); } while (0)
#define CONV_ITEM_B(ly, r_) do { int r = (r_); \
    if (r < IT_G) { p0_item(IN(I_WG) + (size_t)(ly) * DM * FF, DM, FF, G_WGU + (size_t)(ly) * NGU * DM, IN(I_GFFN) + (ly) * DM, 1, scr, r, lane); break; } r -= IT_G; \
    p0_item(IN(I_WU) + (size_t)(ly) * DM * FF, DM, FF, G_WGU + (size_t)(ly) * NGU * DM, IN(I_GFFN) + (ly) * DM, 2, scr, r, lane); } while (0)

constexpr int KS_STRIDE = 144, KS_BYTES = 256 * KS_STRIDE, VT_OFF = KS_BYTES;
typedef short v4i16_t __attribute__((ext_vector_type(4)));
__device__ __forceinline__ u32x2 vtr(const LAS unsigned char* p) { return __builtin_bit_cast(u32x2, __builtin_amdgcn_ds_read_tr16_b64_v4i16((LAS v4i16_t*)p)); }
__device__ __forceinline__ void band_load_kv(u32x4 (&kr)[4], u32x4 (&vr)[4], const bf16_t* K, const bf16_t* V, int ldkv, int kvcol, int rowbase, int dil, int res, int s0, bool has_prev, int tid) {
#pragma unroll
    for (int it = 0; it < 4; ++it) {
        const int idx = tid + 512 * it, key = idx >> 3, ch = idx & 7;
        const int s = s0 - 128 + key; const bool ok = has_prev || key >= 128;
        const size_t roff = (size_t)(rowbase + dil * (ok ? s : s0) + res) * ldkv + kvcol + ch * 8;
        kr[it] = *(const u32x4*)(K + roff); vr[it] = *(const u32x4*)(V + roff);
        if (!ok) { kr[it] = (u32x4){0u, 0u, 0u, 0u}; vr[it] = kr[it]; }
    }
}
__device__ __forceinline__ void band_store_kv(LAS unsigned char* lds, const u32x4 (&kr)[4], const u32x4 (&vr)[4], int tid) {
#pragma unroll
    for (int it = 0; it < 4; ++it) {
        const int idx = tid + 512 * it, key = idx >> 3, ch = idx & 7;
        *(LAS u32x4*)(lds + key * KS_STRIDE + ch * 16) = kr[it];
        *(LAS u32x4*)(lds + VT_OFF + key * KS_STRIDE + ch * 16) = vr[it];
    }
}
__device__ __forceinline__ void band_head(LAS unsigned char* lds, const bf16x8 q0, const bf16x8 q1  , bool has_prev, int w, int lane, f32x4 (&o)[4], float& mrow, float& lrow) {
    const int fr = lane & 15, fq = lane >> 4;
    f32x4 st[10];
#pragma unroll
    for (int T = 0; T < 9; ++T) {
        const LAS unsigned char* kp = lds + (16 * (w + T) + fr) * KS_STRIDE + fq * 16;
        const bf16x8 k0 = *(const LAS bf16x8*)kp, k1 = *(const LAS bf16x8*)(kp + 64);
        f32x4 a = (f32x4){0.f, 0.f, 0.f, 0.f};
        a = __builtin_amdgcn_mfma_f32_16x16x32_bf16(k0, q0, a, 0, 0, 0);
        a = __builtin_amdgcn_mfma_f32_16x16x32_bf16(k1, q1, a, 0, 0, 0);
        st[T] = a;
        if (T & 1) __builtin_amdgcn_sched_barrier(0);
    }
    float mx = -INFINITY;
#pragma unroll
    for (int T = 0; T < 9; ++T)
#pragma unroll
        for (int r = 0; r < 4; ++r) {
            const int dlt = 16 * T + 4 * fq + r - fr;
            const int j = 16 * (w + T) + 4 * fq + r;
            const bool ok = dlt >= 0 && dlt <= 128 && (has_prev || j >= 128);
            const float s = ok ? st[T][r] : -INFINITY; st[T][r] = s; mx = fmaxf(mx, s);
        }
    mx = fmaxf(mx, __shfl_xor(mx, 16)); mx = fmaxf(mx, __shfl_xor(mx, 32));
    float ls = 0.f;
#pragma unroll
    for (int T = 0; T < 9; ++T)
#pragma unroll
        for (int r = 0; r < 4; ++r) { const float p = __builtin_amdgcn_exp2f(st[T][r] - mx); st[T][r] = p; ls += p; }
    st[9] = (f32x4){0.f, 0.f, 0.f, 0.f};
    ls += __shfl_xor(ls, 16); ls += __shfl_xor(ls, 32);
#pragma unroll
    for (int dt = 0; dt < 4; ++dt) o[dt] = (f32x4){0.f, 0.f, 0.f, 0.f};
#pragma unroll
    for (int pp = 0; pp < 5; ++pp) {
        u32x4 pw; pw.x = pk2(st[2 * pp][0], st[2 * pp][1]); pw.y = pk2(st[2 * pp][2], st[2 * pp][3]); pw.z = pk2(st[2 * pp + 1][0], st[2 * pp + 1][1]); pw.w = pk2(st[2 * pp + 1][2], st[2 * pp + 1][3]);
        const bf16x8 pf = __builtin_bit_cast(bf16x8, pw);
        const int kt0 = w + 2 * pp, kt1 = (kt0 + 1 > 15) ? 15 : kt0 + 1;
#pragma unroll
        for (int dt = 0; dt < 4; ++dt) {
            const LAS unsigned char* vp = lds + VT_OFF + (4 * fq + ((lane >> 2) & 3)) * KS_STRIDE + (lane & 3) * 8 + dt * 32;
            const u32x2 va = vtr(vp + kt0 * 16 * KS_STRIDE), vb = vtr(vp + kt1 * 16 * KS_STRIDE);
            u32x4 vw; vw.x = va.x; vw.y = va.y; vw.z = vb.x; vw.w = vb.y;
            o[dt] = __builtin_amdgcn_mfma_f32_16x16x32_bf16(__builtin_bit_cast(bf16x8, vw), pf, o[dt], 0, 0, 0);
        }
        __builtin_amdgcn_sched_barrier(0);
    }
    mrow = mx; lrow = ls;
}

template <int NBR>
__device__ __forceinline__ void dec_attn(const bf16_t* q, const float* Kc, const float* Vc, const float* Kn, const float* Vn, int rs, int nbuf, int t, int lane, f32x4& oout, float& lse) {
    const int sub = lane >> 4, c = lane & 15;
    const u32x2 qw = *(const u32x2*)(q + 4 * c);
    const f32x4 q4 = (f32x4){bf2f((unsigned short)(qw.x & 0xffffu)), bf2f((unsigned short)(qw.x >> 16)), bf2f((unsigned short)(qw.y & 0xffffu)), bf2f((unsigned short)(qw.y >> 16))};
    float m = -INFINITY, l = 0.f; f32x4 acc = (f32x4){0.f, 0.f, 0.f, 0.f};
#pragma unroll 1
    for (int bb = 0; bb < NBR * 3; ++bb) {
        const int br = bb / 3, jb = bb - 3 * br; const int dil = br == 0 ? 1 : (br == 1 ? 4 : 16);
        f32x4 k4[11], v4[11]; float s[11]; float bm = -INFINITY;
#pragma unroll
        for (int u = 0; u < 11; ++u) {
            const int jt = 11 * jb + u; const int j = 4 * jt + sub; const bool ok = jt < 32 || sub == 0;
            const int idx = nbuf + t - dil * (ok ? j : 0);
            const float* kp = idx < nbuf ? Kc + (size_t)idx * rs : Kn + (size_t)(idx - nbuf) * rs;
            const float* vp = idx < nbuf ? Vc + (size_t)idx * rs : Vn + (size_t)(idx - nbuf) * rs;
            k4[u] = *(const f32x4*)(kp + 4 * c); v4[u] = *(const f32x4*)(vp + 4 * c);
        }
#pragma unroll
        for (int u = 0; u < 11; ++u) {
            const int jt = 11 * jb + u; const bool ok = jt < 32 || sub == 0;
            float x = (q4[0] * k4[u][0] + q4[1] * k4[u][1]) + (q4[2] * k4[u][2] + q4[3] * k4[u][3]);
            x = row16_sum(x); if (!ok) x = -INFINITY;
            s[u] = x; bm = fmaxf(bm, x);
        }
        const float mn = fmaxf(m, bm), corr = __builtin_amdgcn_exp2f(m - mn);
        l *= corr; acc = acc * corr; m = mn;
#pragma unroll
        for (int u = 0; u < 11; ++u) { const float p = __builtin_amdgcn_exp2f(s[u] - mn); l += p; acc = acc + v4[u] * p; }
    }
#pragma unroll
    for (int o = 16; o <= 32; o <<= 1) {
        const float mo = __shfl_xor(m, o), lo = __shfl_xor(l, o);
        f32x4 ao; ao[0] = __shfl_xor(acc[0], o); ao[1] = __shfl_xor(acc[1], o); ao[2] = __shfl_xor(acc[2], o); ao[3] = __shfl_xor(acc[3], o);
        const float mn = fmaxf(m, mo), c0 = __builtin_amdgcn_exp2f(m - mn), c1 = __builtin_amdgcn_exp2f(mo - mn);
        l = l * c0 + lo * c1; acc = acc * c0 + ao * c1; m = mn;
    }
    oout = acc * (1.0f / l); lse = (m + __builtin_amdgcn_logf(l)) * LN2F;
}

constexpr int XL_STRIDE = 528;
constexpr int PRE_WOFF = 68096, PRE_WS = 208;
__device__ __forceinline__ void rwkv_stage_weights(LAS unsigned char* lds, const bf16_t* wlt, int h, int tid) {
    for (int idx = tid; idx < 3 * 64 * 12; idx += 512) {
        const int mat = idx / 768, rem = idx - 768 * mat, row = rem / 12, chn = rem - 12 * row;
        *(LAS u32x4*)(lds + PRE_WOFF + (mat * 64 + row) * PRE_WS + chn * 16) = *(const u32x4*)(wlt + (size_t)mat * 512 * 96 + (size_t)(h * 64 + row) * 96 + chn * 8);
    }
}
struct RwkvW { const float *mu, *w0, *a0, *kk, *ka, *rk; const bf16_t* wlt; };
__device__ __forceinline__ void rwkv_prepass_tile(LAS unsigned char* lds, const float* PB, int prow0, const float* prev0, int ntok, int h, const RwkvW& W, float* OPS, float* GG, float* BON, int th0, int tid_in, int w) {
    int tid = tid_in; asm volatile("" : "+v"(tid));
    const int lane = tid & 63;
    {
        const int k = (tid & 63) * 4;
        const f32x4 mu4 = *(const f32x4*)(W.mu + 1536 + k);
        const f32x4 z4 = (f32x4){0.f, 0.f, 0.f, 0.f};
#define PRE_LOAD(i0_, cd, pd) do { _Pragma("unroll") for (int u = 0; u < 8; ++u) { \
            const int i = (i0_) + 8 * u; const int ii = i < ntok ? i : 0; \
            cd[u] = *(const f32x4*)(PB + (size_t)(prow0 + ii) * BCOLS + 1536 + k); \
            const float* pp = ii > 0 ? PB + (size_t)(prow0 + ii - 1) * BCOLS : prev0; \
            pd[u] = pp ? *(const f32x4*)(pp + 1536 + k) : z4; } } while (0)
        f32x4 cur[8], prv[8], curn[8], prvn[8];
        PRE_LOAD(w, cur, prv);
#pragma unroll 1
        for (int i0 = w; i0 < ntok; i0 += 64) {
            if (i0 + 64 < ntok) PRE_LOAD(i0 + 64, curn, prvn);
#pragma unroll
            for (int u = 0; u < 8; ++u) {
                const int i = i0 + 8 * u;
                f32x4 x = cur[u] + (prv[u] - cur[u]) * mu4;
                if (k < 96) { x[0] = tanhf_(x[0]); x[1] = tanhf_(x[1]); x[2] = tanhf_(x[2]); x[3] = tanhf_(x[3]); }
                else if (k >= 192) { x[0] = sigmoidf_(x[0]); x[1] = sigmoidf_(x[1]); x[2] = sigmoidf_(x[2]); x[3] = sigmoidf_(x[3]); }
                u32x2 o; o.x = pk2(x[0], x[1]); o.y = pk2(x[2], x[3]);
                if (i < ntok) *(LAS u32x2*)(lds + i * XL_STRIDE + k * 2) = o;
            }
#pragma unroll
            for (int u = 0; u < 8; ++u) { cur[u] = curn[u]; prv[u] = prvn[u]; }
        }
#undef PRE_LOAD
    }
    __syncthreads();
#pragma unroll 1
    for (int mt = w; 16 * mt < ntok; mt += 8) {
        int lane2 = lane; asm volatile("" : "+v"(lane2));
        const int fr = lane2 & 15, fq = lane2 >> 4;
        const int i = 16 * mt + fr; const bool tok_ok = i < ntok; const int ic = tok_ok ? i : 0;
        f32x4 aw[4], aa[4], ag[4];
#pragma unroll
        for (int nt = 0; nt < 4; ++nt) { aw[nt] = (f32x4){0.f, 0.f, 0.f, 0.f}; aa[nt] = aw[nt]; ag[nt] = aw[nt]; }
        const LAS unsigned char* xrow = lds + (16 * mt + fr) * XL_STRIDE + fq * 16;
#pragma unroll
        for (int ks = 0; ks < 3; ++ks) {
            const bf16x8 xw = *(const LAS bf16x8*)(xrow + ks * 64), xa = *(const LAS bf16x8*)(xrow + 192 + ks * 64);
            bf16x8 xg = xw; if (ks < 2) xg = *(const LAS bf16x8*)(xrow + 384 + ks * 64);
#pragma unroll
            for (int nt = 0; nt < 4; ++nt) {
                const LAS unsigned char* wp = lds + PRE_WOFF + (16 * nt + fr) * PRE_WS + ks * 64 + fq * 16;
                aw[nt] = __builtin_amdgcn_mfma_f32_16x16x32_bf16(*(const LAS bf16x8*)wp, xw, aw[nt], 0, 0, 0);
                aa[nt] = __builtin_amdgcn_mfma_f32_16x16x32_bf16(*(const LAS bf16x8*)(wp + 64 * PRE_WS), xa, aa[nt], 0, 0, 0);
                if (ks < 2) ag[nt] = __builtin_amdgcn_mfma_f32_16x16x32_bf16(*(const LAS bf16x8*)(wp + 128 * PRE_WS), xg, ag[nt], 0, 0, 0);
            }
            __builtin_amdgcn_sched_barrier(0);
        }
        const float* cur = PB + (size_t)(prow0 + ic) * BCOLS;
        const float* prv = ic > 0 ? PB + (size_t)(prow0 + ic - 1) * BCOLS : prev0;
        const f32x4 z4 = (f32x4){0.f, 0.f, 0.f, 0.f};
        f32x4 cr[4], ck[4], cv[4], pr[4], pk[4], pv[4];
#pragma unroll
        for (int nt = 0; nt < 4; ++nt) {
            const int ch = h * 64 + 16 * nt + 4 * fq;
            cr[nt] = *(const f32x4*)(cur + ch); ck[nt] = *(const f32x4*)(cur + 512 + ch); cv[nt] = *(const f32x4*)(cur + 1024 + ch);
            pr[nt] = prv ? *(const f32x4*)(prv + ch) : z4; pk[nt] = prv ? *(const f32x4*)(prv + 512 + ch) : z4; pv[nt] = prv ? *(const f32x4*)(prv + 1024 + ch) : z4;
        }
        float nrm = 0.f;
#pragma unroll
        for (int nt = 0; nt < 4; ++nt) {
            const int ch = h * 64 + 16 * nt + 4 * fq;
            const f32x4 mk = *(const f32x4*)(W.mu + 512 + ch), kk = *(const f32x4*)(W.kk + ch);
            ck[nt] = ck[nt] + (pk[nt] - ck[nt]) * mk;
            const f32x4 kp = ck[nt] * kk;
            nrm += (kp[0] * kp[0] + kp[1] * kp[1]) + (kp[2] * kp[2] + kp[3] * kp[3]);
        }
        nrm += __shfl_xor(nrm, 16); nrm += __shfl_xor(nrm, 32);
        const float inv = 1.0f / fmaxf(sqrtf(nrm), 1e-12f);
        float bon = 0.f;
        float* op = OPS + (size_t)(th0 + ic) * 384; float* gp = GG + (size_t)(th0 + ic) * 64;
#pragma unroll
        for (int nt = 0; nt < 4; ++nt) {
            const int ch = h * 64 + 16 * nt + 4 * fq, cc = 16 * nt + 4 * fq;
            const f32x4 mr = *(const f32x4*)(W.mu + ch), mv = *(const f32x4*)(W.mu + 1024 + ch);
            const f32x4 rs = cr[nt] + (pr[nt] - cr[nt]) * mr, ksh = ck[nt], vs = cv[nt] + (pv[nt] - cv[nt]) * mv;
            const f32x4 w0 = *(const f32x4*)(W.w0 + ch), a0 = *(const f32x4*)(W.a0 + ch), kk = *(const f32x4*)(W.kk + ch), ka = *(const f32x4*)(W.ka + ch), rk = *(const f32x4*)(W.rk + ch);
            f32x4 dv, av, kmod;
#pragma unroll
            for (int r = 0; r < 4; ++r) {
                const float wp = w0[r] + aw[nt][r];
                const float sp = (-wp > 20.f) ? -wp : LN2F * __builtin_amdgcn_logf(1.0f + __builtin_amdgcn_exp2f(-1.4426950408889634f * wp));
                dv[r] = __builtin_amdgcn_exp2f(-1.4426950408889634f * __builtin_amdgcn_exp2f(1.4426950408889634f * (-sp - 0.5f)));
                const float a = sigmoidf_(a0[r] + aa[nt][r]); av[r] = a;
                kmod[r] = ksh[r] * (1.0f + (a - 1.0f) * ka[r]);
                bon += rs[r] * kmod[r] * rk[r];
            }
            const f32x4 kkn = ksh * kk * inv;
            if (tok_ok) {
                *(f32x4*)(op + 0 * 64 + cc) = kkn; *(f32x4*)(op + 1 * 64 + cc) = dv; *(f32x4*)(op + 2 * 64 + cc) = kkn * av;
                *(f32x4*)(op + 3 * 64 + cc) = kmod; *(f32x4*)(op + 4 * 64 + cc) = rs; *(f32x4*)(op + 5 * 64 + cc) = vs;
                *(f32x4*)(gp + cc) = ag[nt];
            }
        }
        bon += __shfl_xor(bon, 16); bon += __shfl_xor(bon, 32);
        if (tok_ok && fq == 0) BON[th0 + i] = bon;
    }
    __syncthreads();
}

__device__ __forceinline__ float row8_sum(float v) {
    v = DPP_ADD(v, 0xB1);
    v = DPP_ADD(v, 0x4E);
    v = DPP_ADD(v, 0x141);
    return v;
}
__device__ __forceinline__ float dot8(const f32x2 (&s)[4], const f32x2 (&o)[4]) { f32x2 a = s[0] * o[0]; a = s[1] * o[1] + a; a = s[2] * o[2] + a; a = s[3] * o[3] + a; return a.x + a.y; }
template <bool WITH_P>
__device__ __forceinline__ void rwkv_scan_t(LAS unsigned char* lds, const float* OPS, int th0, int nsteps, const float* init  , float* yz, int ystride, float* zend, float* pend, int tid, int w) {
    int lane = tid & 63; asm volatile("" : "+v"(lane));
    const int r = lane >> 3, jl = lane & 7, row = 8 * w + r;
    f32x2 Z[4], P[4];
#pragma unroll
    for (int q = 0; q < 4; ++q) {
        const int j = 8 * jl + 2 * q;
        P[q] = (f32x2){row == j ? 1.f : 0.f, row == j + 1 ? 1.f : 0.f};
        Z[q] = init ? *(const f32x2*)(init + row * 64 + j) : (f32x2){0.f, 0.f};
    }
    const f32x4* src = (const f32x4*)(OPS + (size_t)th0 * 384);
    const int nchunks = (nsteps + 31) >> 5;
    f32x4 pre[6];
#pragma unroll
    for (int k = 0; k < 6; ++k) { const int q = tid + 512 * k; pre[k] = (q < nsteps * 96) ? src[q] : (f32x4){0.f, 0.f, 0.f, 0.f}; }
#pragma unroll
    for (int k = 0; k < 6; ++k) *(LAS f32x4*)(lds + (size_t)(tid + 512 * k) * 16) = pre[k];
    for (int c = 0; c < nchunks; ++c) {
        __syncthreads();
        const bool more = c + 1 < nchunks;
        if (more) {
            int t2 = tid; asm volatile("" : "+v"(t2));
            const f32x4* s2 = (const f32x4*)(OPS + (size_t)th0 * 384) + (c + 1) * 3072 + t2;
#pragma unroll
            for (int k = 0; k < 6; ++k) { const int q = (c + 1) * 3072 + t2 + 512 * k; pre[k] = (q < nsteps * 96) ? s2[512 * k] : (f32x4){0.f, 0.f, 0.f, 0.f}; }
        }
        const LAS unsigned char* buf = lds + (c & 1) * 49152;
        const int nst = (nsteps - 32 * c) < 32 ? (nsteps - 32 * c) : 32;
#pragma unroll 1
        for (int t8 = 0; t8 < nst; t8 += 8) {
            float qz[8], qp[8];
#pragma unroll
            for (int u = 0; u < 8; ++u) {
                const LAS float* op = (const LAS float*)(buf + (t8 + u) * 1536) + 8 * jl;
                f32x2 kk[4], d[4], b[4], k[4], rr[4];
                { const f32x4 a0 = *(const LAS f32x4*)(op), a1 = *(const LAS f32x4*)(op + 4); kk[0] = (f32x2){a0[0], a0[1]}; kk[1] = (f32x2){a0[2], a0[3]}; kk[2] = (f32x2){a1[0], a1[1]}; kk[3] = (f32x2){a1[2], a1[3]}; }
                { const f32x4 a0 = *(const LAS f32x4*)(op + 64), a1 = *(const LAS f32x4*)(op + 68); d[0] = (f32x2){a0[0], a0[1]}; d[1] = (f32x2){a0[2], a0[3]}; d[2] = (f32x2){a1[0], a1[1]}; d[3] = (f32x2){a1[2], a1[3]}; }
                { const f32x4 a0 = *(const LAS f32x4*)(op + 128), a1 = *(const LAS f32x4*)(op + 132); b[0] = (f32x2){a0[0], a0[1]}; b[1] = (f32x2){a0[2], a0[3]}; b[2] = (f32x2){a1[0], a1[1]}; b[3] = (f32x2){a1[2], a1[3]}; }
                { const f32x4 a0 = *(const LAS f32x4*)(op + 192), a1 = *(const LAS f32x4*)(op + 196); k[0] = (f32x2){a0[0], a0[1]}; k[1] = (f32x2){a0[2], a0[3]}; k[2] = (f32x2){a1[0], a1[1]}; k[3] = (f32x2){a1[2], a1[3]}; }
                { const f32x4 a0 = *(const LAS f32x4*)(op + 256), a1 = *(const LAS f32x4*)(op + 260); rr[0] = (f32x2){a0[0], a0[1]}; rr[1] = (f32x2){a0[2], a0[3]}; rr[2] = (f32x2){a1[0], a1[1]}; rr[3] = (f32x2){a1[2], a1[3]}; }
                const float vv = *((const LAS float*)(buf + (t8 + u) * 1536) + 320 + row);
                const float saz = -row8_sum(dot8(Z, kk));
                float sap = 0.f; if (WITH_P) sap = -row8_sum(dot8(P, kk));
#pragma unroll
                for (int q = 0; q < 4; ++q) { Z[q] = Z[q] * d[q] + (b[q] * saz + k[q] * vv); if (WITH_P) P[q] = P[q] * d[q] + b[q] * sap; }
                qz[u] = dot8(Z, rr); if (WITH_P) qp[u] = dot8(P, rr);
            }
            float yzv = 0.f, ypv = 0.f;
#pragma unroll
            for (int u = 0; u < 8; ++u) { const float s = row8_sum(qz[u]); yzv = (jl == u) ? s : yzv; if (WITH_P) { const float s2 = row8_sum(qp[u]); ypv = (jl == u) ? s2 : ypv; } }
            int l3 = lane; asm volatile("" : "+v"(l3));
            float* yp = yz + (size_t)(32 * c + t8 + (l3 & 7)) * ystride + 8 * w + (l3 >> 3);
            if (t8 + (l3 & 7) < nst) { *yp = yzv; if (WITH_P) yp[64] = ypv; }
        }
        if (more) {
            LAS unsigned char* nb = lds + ((c + 1) & 1) * 49152;
#pragma unroll
            for (int k = 0; k < 6; ++k) *(LAS f32x4*)(nb + (size_t)(tid + 512 * k) * 16) = pre[k];
        }
    }
    {
        int l2 = lane; asm volatile("" : "+v"(l2));
        const int o = (8 * w + (l2 >> 3)) * 64 + 8 * (l2 & 7);
#pragma unroll
        for (int q = 0; q < 4; ++q) { *(f32x2*)(zend + o + 2 * q) = Z[q]; if (WITH_P) *(f32x2*)(pend + o + 2 * q) = P[q]; }
    }
    __syncthreads();
}
__device__ __forceinline__ void rwkv_scan(LAS unsigned char* lds, const float* OPS, int th0, int nsteps, const float* init, bool with_p, float* yz, int ystride, float* zend, float* pend, int tid, int w) {
    if (with_p) rwkv_scan_t<true>(lds, OPS, th0, nsteps, init, yz, ystride, zend, pend, tid, w);
    else rwkv_scan_t<false>(lds, OPS, th0, nsteps, init, yz, ystride, zend, pend, tid, w);
}

__device__ __forceinline__ void rwkv_out_token(float y, float lw, float lb, float bon, float v, float g, bf16_t* dst) {
    const float mean = wave_sum(y) * (1.0f / 64.0f); const float dlt = y - mean;
    const float var = wave_sum(dlt * dlt) * (1.0f / 64.0f);
    const float yn = dlt * rsqrtf(var + GN_EPS) * lw + lb;
    *dst = (bf16_t)f2bf((yn + bon * v) * g);
}

#ifndef REP_M1A
#define REP_M1A 1
#endif
#ifndef REP_M1B
#define REP_M1B 1
#endif
#ifndef REP_M1C
#define REP_M1C 1
#endif
#ifndef REP_M1D
#define REP_M1D 1
#endif
#ifndef REP_PIN
#define REP_PIN 1
#endif
#ifndef REP_M2
#define REP_M2 1
#endif
#ifndef REP_PGU
#define REP_PGU 1
#endif
#ifndef REP_POUT
#define REP_POUT 1
#endif
#ifndef REP_PDN
#define REP_PDN 1
#endif
struct Args { const float* in[28]; float* out; unsigned char* ws; };
enum { I_XP = 0, I_XS, I_CAK, I_CAV, I_CCK, I_CCV, I_WKV, I_SHIFT, I_GMIX, I_WIN, I_WOUT, I_MU, I_W0, I_W2, I_A0, I_A2, I_G2, I_KK, I_KA, I_RK, I_LNW, I_LNB, I_SINK, I_GFFN, I_WG, I_WU, I_WD, I_GFIN };

#define G_SSQ ((float*)(ws + WS_CTL + SSQ_OFF))
#define G_ROPE ((float*)(ws + WS_ROPE))
#define G_WLT ((bf16_t*)(ws + WS_WLT))
#define G_X ((float*)(ws + WS_X))
#define G_XN ((bf16_t*)(ws + WS_XN))
#define G_QA ((bf16_t*)(ws + WS_QA))
#define G_KA ((bf16_t*)(ws + WS_KA))
#define G_VA ((bf16_t*)(ws + WS_VA))
#define G_QC ((bf16_t*)(ws + WS_QC))
#define G_KC ((bf16_t*)(ws + WS_KC))
#define G_VC ((bf16_t*)(ws + WS_VC))
#define G_PB ((float*)(ws + WS_PB))
#define G_MIX ((bf16_t*)(ws + WS_MIX))
#define G_ACT ((bf16_t*)(ws + WS_ACT))
#define G_OA ((bf16_t*)(ws + WS_OA))
#define G_LSE ((float*)(ws + WS_LSE))
#define G_OPS ((float*)(ws + WS_OPS))
#define G_GG ((float*)(ws + WS_GG))
#define G_BON ((float*)(ws + WS_BON))
#define G_YZ ((float*)(ws + WS_YZ))
#define G_YS ((float*)(ws + WS_YS))
#define G_ENDS ((float*)(ws + WS_ENDS))
#define G_PART ((float*)(ws + WS_PART))
#define G_WIN ((bf16_t*)(ws + WS_WIN))
#define G_WOUT ((bf16_t*)(ws + WS_WOUT))
#define G_WGU ((bf16_t*)(ws + WS_WGU))
#define G_WDN ((bf16_t*)(ws + WS_WDN))
constexpr int PTAB_OFF = RING_BYTES + 1024;
template <class T> __device__ __forceinline__ T* ldptr(LAS unsigned char* lds, int i) {
    unsigned lo, hi; const unsigned addr = (unsigned)(uintptr_t)(lds + PTAB_OFF + 8 * i);
    asm volatile("v_mov_b32 %0, %2\n\tv_mov_b32 %1, %2\n\tds_read_b32 %0, %0\n\tds_read_b32 %1, %1 offset:4\n\ts_waitcnt lgkmcnt(0)" : "=&v"(lo), "=&v"(hi) : "s"(addr) : "memory");
    lo = __builtin_amdgcn_readfirstlane(lo); hi = __builtin_amdgcn_readfirstlane(hi);
    typedef __attribute__((address_space(1))) T GT;
    return (T*)(GT*)(((unsigned long long)hi << 32) | lo);
}
#define IN(i) ldptr<const float>(lds, (i))
#define GRID_BAR() do { XcdBarrier b_; b_.bar = (unsigned*)(ldptr<unsigned char>(lds, 29) + WS_CTL) + CW_BAR; b_.x = xb_xcc_id(); b_.st = (volatile LAS unsigned*)(lds + MISC_OFF) + 8; \
    int ln_; asm volatile("v_mbcnt_lo_u32_b32 %0, -1, 0\n\tv_mbcnt_hi_u32_b32 %0, -1, %0" : "=v"(ln_)); xcd_barrier(b_, wave0 == 0 && ln_ == 0); } while (0)
#define PHASE_BEGIN \
    int wave = wave0; asm volatile("" : "+s"(wave)); int vcu = vcu0; asm volatile("" : "+s"(vcu)); \
    int lane; asm volatile("v_mbcnt_lo_u32_b32 %0, -1, 0\n\tv_mbcnt_hi_u32_b32 %0, -1, %0" : "=v"(lane)); const int tid = wave * 64 + lane; (void)tid; \
    unsigned char* ws = ldptr<unsigned char>(lds, 29); float* out = ldptr<float>(lds, 28); (void)out; \
    const int gw = vcu * 8 + wave, gt = vcu * 512 + tid; (void)gw; (void)gt;

__global__ void __launch_bounds__(512, 2) fwd(Args args) {
    extern __shared__ __attribute__((aligned(16))) unsigned char lds_raw[];
    LAS unsigned char* lds = (LAS unsigned char*)lds_raw;
    const int tid0 = threadIdx.x, wave0 = __builtin_amdgcn_readfirstlane(tid0 >> 6);
    const int G = gridDim.x, bx = blockIdx.x;
    const int vcu0 = (G % 8 == 0) ? (bx % 8) * (G / 8) + bx / 8 : bx;
    const int NGW = G * 8, NGT = G * 512;
    volatile LAS unsigned* MISC = (volatile LAS unsigned*)(lds + MISC_OFF);
    for (int u = tid0; u < (LDS_BYTES - RING_BYTES) / 4; u += 512) ((LAS unsigned*)(lds + RING_BYTES))[u] = 0u;
    __syncthreads();
    if (tid0 == 0) {
#pragma unroll
        for (int i = 0; i < 28; ++i) *(LAS unsigned long long*)(lds + PTAB_OFF + 8 * i) = (unsigned long long)args.in[i];
        *(LAS unsigned long long*)(lds + PTAB_OFF + 8 * 28) = (unsigned long long)args.out;
        *(LAS unsigned long long*)(lds + PTAB_OFF + 8 * 29) = (unsigned long long)args.ws;
    }
    __syncthreads();
    (void)xcd_barrier_post((unsigned*)(args.ws + WS_CTL) + CW_BAR, MISC + 8);

#ifndef SKIP_P0
    {
        PHASE_BEGIN
        LAS unsigned char* scr = lds + wave * 16384;
        for (int it = gw; it < IT_IN; it += NGW) CONV_ITEM_A(0, it);
        for (int e = gt; e < DEPTH * 3 * 512 * 96; e += NGT) {
            const int k = e % 96, ch = (e / 96) % 512, mat = (e / (96 * 512)) % 3, l = e / (96 * 512 * 3);
            float v = 0.f;
            if (mat == 0) v = IN(I_W2)[((size_t)l * 96 + k) * 512 + ch];
            else if (mat == 1) v = IN(I_A2)[((size_t)l * 96 + k) * 512 + ch];
            else if (k < 64) v = IN(I_G2)[((size_t)l * 64 + k) * 512 + ch];
            G_WLT[e] = (bf16_t)f2bf(v);
        }
        for (int e = gt; e < 2056 * 8; e += NGT) {
            const int pi = e >> 3, i = e & 7; const int pos = pi < SEQ ? pi : PASTLEN + (pi - SEQ);
            const float inv = expf(-logf(500000.0f) * (float)i * 2.0f / 16.0f);
            const float ang = (float)pos * inv;
            G_ROPE[pi * 16 + i] = (float)cos((double)ang); G_ROPE[pi * 16 + 8 + i] = (float)sin((double)ang);
        }
        for (int m = gw; m < MTOT; m += NGW) {
            const float* xr = m < MP ? IN(I_XP) + (size_t)m * DM : IN(I_XS) + (size_t)(m - MP) * DM;
            float s = 0.f;
#pragma unroll
            for (int j = 0; j < 8; ++j) { const f32x4 v = *(const f32x4*)(xr + 4 * lane + 256 * j);
                u32x2 o; o.x = pk2(v[0], v[1]); o.y = pk2(v[2], v[3]); *(u32x2*)(G_XN + (size_t)m * DM + 4 * lane + 256 * j) = o;
                s += (v[0] * v[0] + v[1] * v[1]) + (v[2] * v[2] + v[3] * v[3]); }
            s = wave_sum(s); if (lane == 0) G_SSQ[m] = s;
        }
    }
#endif
    GRID_BAR();

    for (int l = 0; l < DEPTH; ++l) {
#ifndef SKIP_PIN
        _Pragma("unroll 1") for (int rep_ = 0; rep_ < REP_PIN; ++rep_) {
            PHASE_BEGIN
            pg8::Gemm g{G_XN, G_WIN + (size_t)l * INC * DM, MTOT, INC, DM, DM}; pg8::StaticOrder S; S.init(MTOT, INC, G, bx);
            pg8::EpiIn E; E.ssq = G_SSQ + (size_t)(2 * l) * MTOT; E.rope = G_ROPE; E.QA = G_QA; E.KA = G_KA; E.VA = G_VA; E.QC = G_QC; E.KC = G_KC; E.VC = G_VC; E.PB = G_PB;
            E.o_ak_p = out + O_AKP + (size_t)l * MP * 512; E.o_av_p = out + O_AVP + (size_t)l * MP * 512; E.o_ck_p = out + O_CKP + (size_t)l * NBATCH * 128 * 128; E.o_cv_p = out + O_CVP + (size_t)l * NBATCH * 128 * 128;
            E.o_sh_p = out + O_SHP + (size_t)l * NBATCH * BCOLS; E.o_ak_s = out + O_AKS + (size_t)l * MS * 512; E.o_av_s = out + O_AVS + (size_t)l * MS * 512;
            E.o_ck_s = out + O_CKS + (size_t)l * MS * 128; E.o_cv_s = out + O_CVS + (size_t)l * MS * 128; E.o_sh_s = out + O_SHS + (size_t)l * DECB * BCOLS;
            pg8::gemm_phase<pg8::EpiIn, pg8::StaticOrder, true, true>(lds, g, S, E, wave);
            constexpr int NIDLE = 256 - ((MTOT / 256) * (INC / 256) - 512);
            if (rep_ == 0 && bx >= 256 - NIDLE) {
                LAS unsigned char* scr = lds + wave * 16384;
                const int nit = (IT_A - IT_IN) + (l + 1 < DEPTH ? IT_IN : 0);
                for (int it = (bx - (256 - NIDLE)) * 8 + wave; it < nit; it += NIDLE * 8) { if (it < IT_A - IT_IN) CONV_ITEM_A(l, IT_IN + it); else CONV_ITEM_A(l + 1, it - (IT_A - IT_IN)); }
                for (int it = (bx - (256 - NIDLE)) * 8 + wave; it < IT_B / 2; it += NIDLE * 8) CONV_ITEM_B(l, it);
            }
        }
#endif
        GRID_BAR();

#ifndef SKIP_M1
        {
            PHASE_BEGIN
#ifndef SKIP_M1A
            _Pragma("unroll 1") for (int rep_ = 0; rep_ < REP_M1A; ++rep_) { PHASE_BEGIN
                RwkvW W; W.mu = IN(I_MU) + l * BCOLS; W.w0 = IN(I_W0) + l * 512; W.a0 = IN(I_A0) + l * 512; W.kk = IN(I_KK) + l * 512; W.ka = IN(I_KA) + l * 512; W.rk = IN(I_RK) + l * 512;
                W.wlt = G_WLT + (size_t)l * 3 * 512 * 96;
            for (int task = vcu; task < 256; task += G) {
                const int seg = task & 7, h = (task >> 3) & 7, b = task >> 6;
                const int prow = b * SEQ + seg * 256, th0 = (b * 8 + h) * SEQ + seg * 256;
                rwkv_stage_weights(lds, W.wlt, h, tid);
#pragma unroll 1
                for (int tt = 0; tt < 2; ++tt) {
                    const int p0 = prow + 128 * tt; const float* prev0 = (seg == 0 && tt == 0) ? nullptr : G_PB + (size_t)(p0 - 1) * BCOLS;
                    rwkv_prepass_tile(lds, G_PB, p0, prev0, 128, h, W, G_OPS, G_GG, G_BON, th0 + 128 * tt, tid, wave);
                }
                rwkv_scan(lds, G_OPS, th0, 256, nullptr, seg > 0, G_YZ + (size_t)th0 * 128, 128, G_ENDS + (size_t)task * 8192, G_ENDS + (size_t)task * 8192 + 4096, tid, wave);
            }
            }
#endif
#ifndef SKIP_M1B
            _Pragma("unroll 1") for (int rep_ = 0; rep_ < REP_M1B; ++rep_) { PHASE_BEGIN
                RwkvW W; W.mu = IN(I_MU) + l * BCOLS; W.w0 = IN(I_W0) + l * 512; W.a0 = IN(I_A0) + l * 512; W.kk = IN(I_KK) + l * 512; W.ka = IN(I_KA) + l * 512; W.rk = IN(I_RK) + l * 512;
                W.wlt = G_WLT + (size_t)l * 3 * 512 * 96;
            for (int task = vcu; task < 256; task += G) {
                const int h = task & 7, b = task >> 3; const int th0 = MP * 8 + task * 8;
                rwkv_stage_weights(lds, W.wlt, h, tid);
                rwkv_prepass_tile(lds, G_PB, MP + b * 8, IN(I_SHIFT) + ((size_t)l * DECB + b) * BCOLS, 8, h, W, G_OPS, G_GG, G_BON, th0, tid, wave);
                float* wo = out + O_WKVS + ((size_t)(l * DECB + b) * 8 + h) * 4096;
                rwkv_scan(lds, G_OPS, th0, 8, IN(I_WKV) + ((size_t)(l * DECB + b) * 8 + h) * 4096, false, G_YS + (size_t)task * 8 * 64, 64, wo, wo, tid, wave);
                {
                    const int t = wave, th = th0 + t;
                    rwkv_out_token(G_YS[(size_t)task * 512 + t * 64 + lane], IN(I_LNW)[l * 512 + h * 64 + lane], IN(I_LNB)[l * 512 + h * 64 + lane], G_BON[th], G_OPS[(size_t)th * 384 + 320 + lane], G_GG[(size_t)th * 64 + lane],
                                   G_MIX + (size_t)(MP + b * 8 + t) * DM + 512 + h * 64 + lane);
                }
            }
            }
#endif
#ifndef SKIP_M1C
            _Pragma("unroll 1") for (int rep_ = 0; rep_ < REP_M1C; ++rep_) { PHASE_BEGIN
            const int w = wave, fr = lane & 15, fq = lane >> 4;
            const int na = vcu < 128 ? 2 : 10;
#define A_TILE(k_) const int a_ = vcu < 128 ? vcu + 128 * (k_) : 256 + (vcu - 128) + 128 * (k_); \
                const int br = a_ >> 9, rem = a_ & 511, b = rem >> 7, h = (rem >> 4) & 7, u = rem & 15; \
                const int dil = br == 0 ? 1 : (br == 1 ? 4 : 16); \
                const int res = br == 0 ? 0 : (br == 1 ? (u >> 2) : u), qt = br == 0 ? u : (br == 1 ? (u & 3) : 0);
            u32x4 kr[4], vr[4];
            if (vcu < 128) {
                const int b = vcu >> 5, kvh = (vcu >> 4) & 1, qt = vcu & 15;
                band_load_kv(kr, vr, G_KC, G_VC, 128, kvh * 64, b * SEQ, 1, 0, 128 * qt, qt > 0, tid);
                band_store_kv(lds, kr, vr, tid);
                __syncthreads();
                { A_TILE(0) band_load_kv(kr, vr, G_KA, G_VA, 512, h * 64, b * SEQ, dil, res, 128 * qt, qt > 0, tid); }
                const int row = b * SEQ + 128 * qt + 16 * w + fr;
                const bf16_t* qp = G_QC + (size_t)row * 1024 + kvh * 512 + 8 * fq;
                bf16x8 qa = *(const bf16x8*)qp, qb = *(const bf16x8*)(qp + 32);
#pragma unroll 1
                for (int gq = 0; gq < 8; ++gq) {
                    const int qh = kvh * 8 + gq; f32x4 o[4]; float mrow, lrow;
                    const bf16x8 q0 = qa, q1 = qb;
                    if (gq + 1 < 8) { qa = *(const bf16x8*)(qp + (gq + 1) * 64); qb = *(const bf16x8*)(qp + (gq + 1) * 64 + 32); }
                    band_head(lds, q0, q1, qt > 0, w, lane, o, mrow, lrow);
                    const float lse = (mrow + __builtin_amdgcn_logf(lrow)) * LN2F;
                    const float sc = sigmoidf_(lse - IN(I_SINK)[l * 16 + qh]) / lrow;
#pragma unroll
                    for (int dt = 0; dt < 4; ++dt) { u32x2 ow; ow.x = pk2(o[dt][0] * sc, o[dt][1] * sc); ow.y = pk2(o[dt][2] * sc, o[dt][3] * sc);
                        *(u32x2*)(G_MIX + (size_t)row * DM + 1024 + qh * 64 + 16 * dt + 4 * fq) = ow; }
                }
            } else {
                A_TILE(0) band_load_kv(kr, vr, G_KA, G_VA, 512, h * 64, b * SEQ, dil, res, 128 * qt, qt > 0, tid);
            }
#pragma unroll 1
            for (int k = 0; k < na; ++k) {
                bf16x8 q0, q1;
                { A_TILE(k) const bf16_t* qp = G_QA + (size_t)(b * SEQ + dil * (128 * qt + 16 * w + fr) + res) * 512 + h * 64 + 8 * fq; q0 = *(const bf16x8*)qp; q1 = *(const bf16x8*)(qp + 32); }
                __syncthreads();
                band_store_kv(lds, kr, vr, tid);
                __syncthreads();
                if (k + 1 < na) { A_TILE(k + 1) band_load_kv(kr, vr, G_KA, G_VA, 512, h * 64, b * SEQ, dil, res, 128 * qt, qt > 0, tid); }
                A_TILE(k)
                const int row = b * SEQ + dil * (128 * qt + 16 * w + fr) + res;
                f32x4 o[4]; float mrow, lrow;
                band_head(lds, q0, q1, qt > 0, w, lane, o, mrow, lrow);
                const float inv = 1.0f / lrow;
#pragma unroll
                for (int dt = 0; dt < 4; ++dt) { u32x2 ow; ow.x = pk2(o[dt][0] * inv, o[dt][1] * inv); ow.y = pk2(o[dt][2] * inv, o[dt][3] * inv); *(u32x2*)(G_OA + ((size_t)br * MP + row) * 512 + h * 64 + 16 * dt + 4 * fq) = ow; }
                if (fq == 0) G_LSE[((size_t)br * MP + row) * 8 + h] = (mrow + __builtin_amdgcn_logf(lrow)) * LN2F;
            }
            __syncthreads();
#undef A_TILE
            }
#endif
#ifndef SKIP_M1D
            _Pragma("unroll 1") for (int rep_ = 0; rep_ < REP_M1D; ++rep_) { PHASE_BEGIN
            for (int wt = gw; wt < DECB * DECS * 8; wt += NGW) {
                const int h = wt & 7, t = (wt >> 3) & 7, b = wt >> 6; const int row = MP + b * 8 + t;
                const size_t cb = ((size_t)(l * DECB + b) * 2048) * 512 + h * 64, nb = ((size_t)(l * DECB + b) * 8) * 512 + h * 64;
                f32x4 o; float lse;
                dec_attn<3>(G_QA + (size_t)row * 512 + h * 64, IN(I_CAK) + cb, IN(I_CAV) + cb, out + O_AKS + nb, out + O_AVS + nb, 512, 2048, t, lane, o, lse);
                if (lane < 16) { u32x2 ow; ow.x = pk2(o[0], o[1]); ow.y = pk2(o[2], o[3]); *(u32x2*)(G_MIX + (size_t)row * DM + h * 64 + 4 * lane) = ow; }
            }
            for (int wt = gw; wt < DECB * DECS * 16; wt += NGW) {
                const int qh = wt & 15, t = (wt >> 4) & 7, b = wt >> 7; const int row = MP + b * 8 + t, kvh = qh >> 3;
                const size_t cb = ((size_t)(l * DECB + b) * 128) * 128 + kvh * 64, nb = ((size_t)(l * DECB + b) * 8) * 128 + kvh * 64;
                f32x4 o; float lse;
                dec_attn<1>(G_QC + (size_t)row * 1024 + qh * 64, IN(I_CCK) + cb, IN(I_CCV) + cb, out + O_CKS + nb, out + O_CVS + nb, 128, 128, t, lane, o, lse);
                const float sc = sigmoidf_(lse - IN(I_SINK)[l * 16 + qh]);
                if (lane < 16) { u32x2 ow; ow.x = pk2(o[0] * sc, o[1] * sc); ow.y = pk2(o[2] * sc, o[3] * sc); *(u32x2*)(G_MIX + (size_t)row * DM + 1024 + qh * 64 + 4 * lane) = ow; }
            }
            }
#endif
        }
#endif
        GRID_BAR();

#ifndef SKIP_M2
        _Pragma("unroll 1") for (int rep_ = 0; rep_ < REP_M2; ++rep_) {
            PHASE_BEGIN
#pragma unroll 4
            for (int it = gt; it < MP * 64; it += NGT) {
                const int dc = it & 7, h = (it >> 3) & 7, row = it >> 6;
                const float l0 = G_LSE[((size_t)0 * MP + row) * 8 + h], l1 = G_LSE[((size_t)1 * MP + row) * 8 + h], l2 = G_LSE[((size_t)2 * MP + row) * 8 + h];
                const float mx = fmaxf(l0, fmaxf(l1, l2)); float w0 = __builtin_amdgcn_exp2f(1.4426950408889634f * (l0 - mx)), w1 = __builtin_amdgcn_exp2f(1.4426950408889634f * (l1 - mx)), w2 = __builtin_amdgcn_exp2f(1.4426950408889634f * (l2 - mx)); const float inv = 1.0f / (w0 + w1 + w2); w0 *= inv; w1 *= inv; w2 *= inv;
                const size_t off = (size_t)row * 512 + h * 64 + dc * 8;
                const u32x4 ua = *(const u32x4*)(G_OA + off), ub = *(const u32x4*)(G_OA + (size_t)MP * 512 + off), uc = *(const u32x4*)(G_OA + (size_t)2 * MP * 512 + off);
#define BF_LO(x) __builtin_bit_cast(float, (x) << 16)
#define BF_HI(x) __builtin_bit_cast(float, (x) & 0xffff0000u)
                const f32x4 a0 = (f32x4){BF_LO(ua.x), BF_HI(ua.x), BF_LO(ua.y), BF_HI(ua.y)}, a1 = (f32x4){BF_LO(ua.z), BF_HI(ua.z), BF_LO(ua.w), BF_HI(ua.w)};
                const f32x4 b0 = (f32x4){BF_LO(ub.x), BF_HI(ub.x), BF_LO(ub.y), BF_HI(ub.y)}, b1 = (f32x4){BF_LO(ub.z), BF_HI(ub.z), BF_LO(ub.w), BF_HI(ub.w)};
                const f32x4 c0 = (f32x4){BF_LO(uc.x), BF_HI(uc.x), BF_LO(uc.y), BF_HI(uc.y)}, c1 = (f32x4){BF_LO(uc.z), BF_HI(uc.z), BF_LO(uc.w), BF_HI(uc.w)};
#undef BF_LO
#undef BF_HI
                const f32x4 r0 = a0 * w0 + b0 * w1 + c0 * w2, r1 = a1 * w0 + b1 * w1 + c1 * w2;
                u32x4 ow; ow.x = pk2(r0[0], r0[1]); ow.y = pk2(r0[2], r0[3]); ow.z = pk2(r1[0], r1[1]); ow.w = pk2(r1[2], r1[3]);
                *(u32x4*)(G_MIX + (size_t)row * DM + h * 64 + dc * 8) = ow;
            }
            LAS float* Sl = (LAS float*)lds;
            LAS float* Pl = (LAS float*)(lds + 17408);
            LAS float* PT = (LAS float*)(lds + 17408 + 20480 + wave * 8192);
            constexpr int PS = 80;
#pragma unroll 1
            for (int task = vcu; task < 256; task += G) {
                const int seg = task & 7, h = (task >> 3) & 7, b = task >> 6;
                const int th0 = (b * 8 + h) * SEQ + seg * 256, prow = b * SEQ + seg * 256;
                const int fi = tid >> 3, fj = (tid & 7) * 8;
                const int tr = wave >> 1, tc0 = (wave & 1) * 2, lr = lane & 15, lq = lane >> 4;
                const int nfold = seg;
                f32x4 pn0, pn1, zt0, zt1;
                __syncthreads();
                for (int i = tid; i < 64 * 68; i += 512) Sl[i] = 0.f;
#define FOLD_LOAD(c) do { const float* ze_ = G_ENDS + (size_t)(task - seg + (c)) * 8192; const float* pe_ = ze_ + 4096; \
                    pn0 = *(const f32x4*)(pe_ + tid * 8); pn1 = *(const f32x4*)(pe_ + tid * 8 + 4); \
                    _Pragma("unroll") for (int i_ = 0; i_ < 4; ++i_) { zt0[i_] = ze_[(tr * 16 + 4 * lq + i_) * 64 + tc0 * 16 + lr]; zt1[i_] = ze_[(tr * 16 + 4 * lq + i_) * 64 + tc0 * 16 + 16 + lr]; } } while (0)
#define FOLD_STEP(has_next, cn) do { \
                    __syncthreads(); \
                    *(LAS f32x4*)(Pl + fi * PS + fj) = pn0; *(LAS f32x4*)(Pl + fi * PS + fj + 4) = pn1; \
                    f32x4 a0 = zt0, a1 = zt1; \
                    __syncthreads(); \
                    if (has_next) FOLD_LOAD(cn); \
                    _Pragma("unroll") for (int kb = 0; kb < 16; ++kb) { \
                        const float av = Sl[(tr * 16 + lr) * 68 + kb * 4 + lq]; \
                        const float b0 = Pl[(kb * 4 + lq) * PS + tc0 * 16 + lr], b1 = Pl[(kb * 4 + lq) * PS + tc0 * 16 + 16 + lr]; \
                        a0 = __builtin_amdgcn_mfma_f32_16x16x4f32(av, b0, a0, 0, 0, 0); a1 = __builtin_amdgcn_mfma_f32_16x16x4f32(av, b1, a1, 0, 0, 0); } \
                    __syncthreads(); \
                    _Pragma("unroll") for (int i_ = 0; i_ < 4; ++i_) { Sl[(tr * 16 + 4 * lq + i_) * 68 + tc0 * 16 + lr] = a0[i_]; Sl[(tr * 16 + 4 * lq + i_) * 68 + tc0 * 16 + 16 + lr] = a1[i_]; } } while (0)
                if (nfold > 0) FOLD_LOAD(0);
#pragma unroll 1
                for (int c = 0; c < nfold; ++c) FOLD_STEP(c + 1 < nfold, c + 1);
                if (seg == 7) FOLD_LOAD(7);
                __syncthreads();
                {
                    const int tb = th0 + 32 * wave;
                    const float lw = IN(I_LNW)[l * 512 + h * 64 + lane], lb = IN(I_LNB)[l * 512 + h * 64 + lane];
                    if (seg > 0) {
#pragma unroll 16
                        for (int tk = 0; tk < 32; ++tk) PT[tk * 64 + lane] = G_YZ[(size_t)(tb + tk) * 128 + 64 + lane];
                        LDS_WAIT(); asm volatile("" ::: "memory");
                    }
                    float yv[4], bo[4], vv[4], gg[4], yn[4], bn[4], vn[4], gn[4];
#pragma unroll
                    for (int u = 0; u < 4; ++u) { const int th = tb + u; yv[u] = G_YZ[(size_t)th * 128 + lane]; bo[u] = G_BON[th]; vv[u] = G_OPS[(size_t)th * 384 + 320 + lane]; gg[u] = G_GG[(size_t)th * 64 + lane]; yn[u] = bn[u] = vn[u] = gn[u] = 0.f; }
#pragma unroll 1
                    for (int t4 = 0; t4 < 32; t4 += 4) {
                        if (t4 + 4 < 32) {
#pragma unroll
                            for (int u = 0; u < 4; ++u) { const int th = tb + t4 + 4 + u; yn[u] = G_YZ[(size_t)th * 128 + lane]; bn[u] = G_BON[th]; vn[u] = G_OPS[(size_t)th * 384 + 320 + lane]; gn[u] = G_GG[(size_t)th * 64 + lane]; }
                        }
#pragma unroll
                        for (int u = 0; u < 4; ++u) {
                            float y = yv[u];
                            if (seg > 0) {
                                float y2 = 0.f;
#pragma unroll
                                for (int q = 0; q < 16; ++q) { const f32x4 p4 = *(const LAS f32x4*)(PT + (t4 + u) * 64 + 4 * q), s4 = *(const LAS f32x4*)(Sl + lane * 68 + 4 * q); y += s4[0] * p4[0] + s4[1] * p4[1]; y2 += s4[2] * p4[2] + s4[3] * p4[3]; }
                                y += y2;
                            }
                            rwkv_out_token(y, lw, lb, bo[u], vv[u], gg[u], G_MIX + (size_t)(prow + 32 * wave + t4 + u) * DM + 512 + h * 64 + lane);
                        }
#pragma unroll
                        for (int u = 0; u < 4; ++u) { yv[u] = yn[u]; bo[u] = bn[u]; vv[u] = vn[u]; gg[u] = gn[u]; }
                    }
                }
                if (seg == 7) { FOLD_STEP(false, 0); __syncthreads(); float* wo = out + O_WKVP + ((size_t)(l * NBATCH + b) * 8 + h) * 4096 + fi * 64 + fj; *(f32x4*)wo = *(const LAS f32x4*)(Sl + fi * 68 + fj); *(f32x4*)(wo + 4) = *(const LAS f32x4*)(Sl + fi * 68 + fj + 4); }
#undef FOLD_STEP
#undef FOLD_LOAD
            }
            __syncthreads();
            if (rep_ == 0) {
                const int seg = vcu & 7;
                if (seg >= 1 && seg <= 4) {
                    LAS unsigned char* scr = lds + wave * 16384;
                    const int widx = ((vcu >> 3) * 4 + (seg - 1)) * 8 + wave;
                    for (int it = IT_B / 2 + widx; it < IT_B; it += 128 * 8) CONV_ITEM_B(l, it);
                    __syncthreads();
                }
            }
            {
                const int task = vcu, seg = task & 7, bh = task >> 3;
                int kslice = 512; asm volatile("" : "+s"(kslice));
                const int pn = bh & 7, ks = bh >> 3;
                pg8::OneUnit S2; S2.pm = 0; S2.pn = pn; S2.have = (rep_ == 0) && seg == 0;
                pg8::Gemm g2{G_MIX + (size_t)MP * DM + ks * 512, G_WOUT + (size_t)l * DM * DM + ks * 512, MS, DM, kslice, DM};
                pg8::EpiPart E2; E2.P = G_PART + (size_t)ks * MS * DM;
                pg8::gemm_phase<pg8::EpiPart, pg8::OneUnit, true, true>(lds, g2, S2, E2, wave);
            }
        }
#endif
        GRID_BAR();

#ifndef SKIP_POUT
        _Pragma("unroll 1") for (int rep_ = 0; rep_ < REP_POUT; ++rep_) {
            PHASE_BEGIN
            if (rep_ == 0) {
                const int row = MP + vcu; const int c = 256 * wave + 4 * lane;
                f32x4 v = l == 0 ? *(const f32x4*)(IN(I_XS) + (size_t)vcu * DM + c) : *(const f32x4*)(G_X + (size_t)row * DM + c);
                const f32x4 p0 = *(const f32x4*)(G_PART + ((size_t)0 * MS + vcu) * DM + c), p1 = *(const f32x4*)(G_PART + ((size_t)1 * MS + vcu) * DM + c);
                const f32x4 p2 = *(const f32x4*)(G_PART + ((size_t)2 * MS + vcu) * DM + c), p3 = *(const f32x4*)(G_PART + ((size_t)3 * MS + vcu) * DM + c);
                v += (p0 + p1) + (p2 + p3);
                *(f32x4*)(G_X + (size_t)row * DM + c) = v; u32x2 o; o.x = pk2(v[0], v[1]); o.y = pk2(v[2], v[3]); *(u32x2*)(G_XN + (size_t)row * DM + c) = o;
                const float s = wave_sum((v[0] * v[0] + v[1] * v[1]) + (v[2] * v[2] + v[3] * v[3]));
                if (lane == 0) unsafeAtomicAdd(G_SSQ + (size_t)(2 * l + 1) * MTOT + row, s);
            }
            pg8::Gemm g{G_MIX, G_WOUT + (size_t)l * DM * DM, MP, DM, DM, DM}; pg8::StaticOrder S; S.init(MP, DM, G, bx);
            pg8::EpiRes E; E.X = G_X; E.Xin = l == 0 ? IN(I_XP) : G_X; E.XN = G_XN; E.ssq_next = G_SSQ + (size_t)(2 * l + 1) * MTOT; E.dry = (rep_ + 1 < REP_POUT);
            pg8::gemm_phase<pg8::EpiRes, pg8::StaticOrder, true, true>(lds, g, S, E, wave);
        }
#endif
        GRID_BAR();
#ifndef SKIP_PGU
        _Pragma("unroll 1") for (int rep_ = 0; rep_ < REP_PGU; ++rep_) {
            PHASE_BEGIN
            pg8::Gemm g{G_XN, G_WGU + (size_t)l * NGU * DM, MTOT, NGU, DM, DM}; pg8::GuOrder S; S.init(G, bx);
            pg8::EpiGU E; E.ssq = G_SSQ + (size_t)(2 * l + 1) * MTOT; E.ACT = G_ACT;
            pg8::gemm_phase<pg8::EpiGU, pg8::GuOrder, true, true>(lds, g, S, E, wave);
            if (bx >= pg8::GuOrder::SPEC0 && rep_ == 0) {
                const int k = bx - pg8::GuOrder::SPEC0;
                int kslice = 256; asm volatile("" : "+s"(kslice));
                pg8::Gemm g2{G_ACT + (size_t)MP * FF + k * 256, G_WDN + (size_t)l * DM * FF + k * 256, MS, DM, kslice, FF};
                pg8::RowUnits S2; S2.nt = DM / 256; S2.have = true;
                pg8::EpiPart E2; E2.P = G_PART + (size_t)k * MS * DM;
                pg8::gemm_phase<pg8::EpiPart, pg8::RowUnits, true, true>(lds, g2, S2, E2, wave);
            }
        }
#endif
        GRID_BAR();
#ifndef SKIP_PDN
        _Pragma("unroll 1") for (int rep_ = 0; rep_ < REP_PDN; ++rep_) {
            PHASE_BEGIN
            if (rep_ == 0) {
                const int row = MP + vcu; const int c = 256 * wave + 4 * lane;
                f32x4 v = *(const f32x4*)(G_X + (size_t)row * DM + c);
                f32x4 pp[22];
#pragma unroll
                for (int kc = 0; kc < 22; ++kc) pp[kc] = *(const f32x4*)(G_PART + ((size_t)kc * MS + vcu) * DM + c);
#pragma unroll
                for (int kc = 0; kc < 22; ++kc) v += pp[kc];
                float s = wave_sum((v[0] * v[0] + v[1] * v[1]) + (v[2] * v[2] + v[3] * v[3]));
                if (l + 1 < DEPTH || G != 256) {
                    *(f32x4*)(G_X + (size_t)row * DM + c) = v; u32x2 o; o.x = pk2(v[0], v[1]); o.y = pk2(v[2], v[3]); *(u32x2*)(G_XN + (size_t)row * DM + c) = o;
                    if (lane == 0) unsafeAtomicAdd(G_SSQ + (size_t)(2 * l + 2) * MTOT + row, s);
                } else {
                    volatile LAS float* sl = (volatile LAS float*)(lds + MISC_OFF + 128);
                    if (lane == 0) sl[wave] = s;
                    __syncthreads();
                    const float tot = ((sl[0] + sl[1]) + (sl[2] + sl[3])) + ((sl[4] + sl[5]) + (sl[6] + sl[7]));
                    const float rstd = rsqrtf(tot * (1.0f / DM) + RMS_EPS);
                    *(f32x4*)(out + (size_t)row * DM + c) = v * rstd * *(const f32x4*)(IN(I_GFIN) + c);
                    __syncthreads();
                }
            }
            pg8::Gemm g{G_ACT, G_WDN + (size_t)l * DM * FF, MP, DM, FF, FF}; pg8::StaticOrder S; S.init(MP, DM, G, bx);
            if (l + 1 < DEPTH || G != 256) {
                pg8::EpiRes E; E.X = G_X; E.Xin = G_X; E.XN = G_XN; E.ssq_next = G_SSQ + (size_t)(2 * l + 2) * MTOT; E.dry = (rep_ + 1 < REP_PDN);
                pg8::gemm_phase<pg8::EpiRes, pg8::StaticOrder, true, true>(lds, g, S, E, wave);
            } else {
                pg8::EpiFinal E; E.X = G_X; E.OUT = out; E.gf = IN(I_GFIN); E.ssq = G_SSQ + (size_t)(2 * DEPTH) * MTOT; E.cnt = (unsigned*)(ws + WS_CTL) + CW_FIN;
                pg8::gemm_phase<pg8::EpiFinal, pg8::StaticOrder, true, true>(lds, g, S, E, wave);
            }
        }
#endif
        if (l + 1 < DEPTH || G != 256) GRID_BAR();
    }
    if (G != 256) {
        PHASE_BEGIN
        const float* ssq = G_SSQ + (size_t)(2 * DEPTH) * MTOT; const float* gf = IN(I_GFIN);
        for (int m = gw; m < MTOT; m += NGW) {
            const float rstd = rsqrtf(ssq[m] * (1.0f / DM) + RMS_EPS);
#pragma unroll
            for (int j = 0; j < 8; ++j) { const int c = 4 * lane + 256 * j; const f32x4 v = *(const f32x4*)(G_X + (size_t)m * DM + c), gg = *(const f32x4*)(gf + c);
                *(f32x4*)(out + (size_t)m * DM + c) = v * rstd * gg; }
        }
    }
}

extern "C" void kernel_launch(void* const* d_in, const int* in_sizes, int n_in, void* d_out, int out_size, void* d_ws, size_t ws_size, hipStream_t stream) {
    static int grid = 0;
    if (grid == 0) {
        if (n_in != 28 || (size_t)out_size != O_END || ws_size < WS_END) { fprintf(stderr, "kernel_launch: unexpected shapes: n_in %d out %d (want %zu) ws %zu (want >= %zu)\n", n_in, out_size, (size_t)O_END, ws_size, (size_t)WS_END); grid = -1; return; }
        int dev = 0, cus = 0;
        if (hipGetDevice(&dev) != hipSuccess || hipDeviceGetAttribute(&cus, hipDeviceAttributeMultiprocessorCount, dev) != hipSuccess) { grid = -1; return; }
        if (hipFuncSetAttribute((const void*)fwd, hipFuncAttributeMaxDynamicSharedMemorySize, LDS_BYTES) != hipSuccess) { fprintf(stderr, "kernel_launch: hipFuncSetAttribute failed\n"); grid = -1; return; }
        int per_cu = 0;
        if (hipOccupancyMaxActiveBlocksPerMultiprocessor(&per_cu, (const void*)fwd, 512, LDS_BYTES) != hipSuccess || per_cu < 1) { fprintf(stderr, "kernel_launch: occupancy query says %d blocks per CU\n", per_cu); }
        (void)hipGetLastError();
        grid = cus;
    }
    if (grid < 0) return;
    if (hipMemsetAsync((char*)d_ws + WS_CTL, 0, CTL_ZERO_BYTES, stream) != hipSuccess) return;
    Args a{};
    for (int i = 0; i < 28; ++i) a.in[i] = (const float*)d_in[i];
    a.out = (float*)d_out; a.ws = (unsigned char*)d_ws;
    hipLaunchKernelGGL(fwd, dim3(grid), dim3(512), LDS_BYTES, stream, a);
}
```

```cpp
#include <hip/hip_runtime.h>
#include <cstdio>
#include <cstdint>

constexpr int DM = 2048, SEQ = 2048, NBATCH = 4, MP = NBATCH * SEQ, DECB = 32, DECS = 8, MS = DECB * DECS, MTOT = MP + MS;
constexpr int DEPTH = 4, BCOLS = 1792, INC = 4608, FF = 5632, NGU = 2 * FF;
constexpr int PASTLEN = 16384;
constexpr float RMS_EPS = 1e-6f, GN_EPS = 64e-5f;
constexpr float QSCALE = 0.125f * 1.4426950408889634f;
constexpr float LN2F = 0.6931471805599453f;
namespace pg8 {
#define PG8_LAS __attribute__((address_space(3)))
typedef unsigned short bf16_t;
typedef short bf16x8 __attribute__((ext_vector_type(8)));
typedef float f32x4 __attribute__((ext_vector_type(4)));
typedef unsigned u32x4 __attribute__((ext_vector_type(4)));
constexpr int BM = 256, BK = 64, HALF = 128, HTB = HALF * BK * 2  , STAGE_BYTES = 8 * HTB, NXCD = 8, WGM = 8;

__host__ __device__ __forceinline__ int lds_byte(int r, int c) { const int st = (r >> 4) * 2 + (c >> 5), rr = r & 15, cc = c & 31, ob = rr * 64 + cc * 2; return st * 1024 + (ob ^ (((ob >> 9) & 1) << 5)); }
__host__ __device__ __forceinline__ void stage_rc(int b, int& R, int& C) { const int st = b / 1024, sb = b % 1024, swz = sb ^ (((sb >> 9) & 1) << 5); R = (st >> 1) * 16 + swz / 64; C = (st & 1) * 32 + (swz % 64) / 2; }
__host__ __device__ __forceinline__ int perm32(int rho) { const int n = rho >> 4, i = rho & 15; return 8 * (i >> 2) + 4 * n + (i & 3); }

struct Unit { int pm, pn; };
struct Gemm { const bf16_t* A; const bf16_t* Bt; int M, N, K, ld; };

struct StaticOrder {
    int nM, nN, nwg, G, c;
    __host__ __device__ void init(int M, int N, int G_, int c_) { nM = M / BM; nN = N / BM; nwg = nM * nN; G = G_; c = c_; }
    __host__ __device__ bool unit_at(long L, Unit& u) const {
        if (L >= nwg) return false;
        int wgid = (int)L; { const int q = nwg / NXCD, r = nwg % NXCD, xcd = wgid % NXCD, off = wgid / NXCD; wgid = (xcd < r ? xcd * (q + 1) : r * (q + 1) + (xcd - r) * q) + off; }
        const int nig = WGM * nN, gid = wgid / nig, fm = gid * WGM, gsz = (nM - fm) < WGM ? (nM - fm) : WGM;
        u.pm = fm + ((wgid % nig) % gsz); u.pn = (wgid % nig) / gsz; return true;
    }
    __host__ __device__ bool next(int i, Unit& u) const { return unit_at((long)i * G + c, u); }
    __device__ __forceinline__ void a_ready(const Unit&) const {}
    __device__ __forceinline__ void done(const Unit&) const {}
};


struct GuOrder {
    StaticOrder so; int c;
    static constexpr int MP_ROWS = 8192, SPEC0 = 234;
    __host__ __device__ void init(int G_, int c_) { so.init(MP_ROWS, 2 * 5632, G_, c_); c = c_; }
    __host__ __device__ bool next(int i, Unit& u) const {
        if (c >= SPEC0) { const int k = c - SPEC0;
            if (i < 2) return so.unit_at((long)i * 256 + c, u);
            if (i < 4) { u.pm = MP_ROWS / 256; u.pn = 2 * k + (i - 2); return true; }
            return false; }
        const int np = c < 128 ? 6 : 5;
        if (i < np) return so.unit_at((long)i * 256 + c, u);
        if (i == 5 && c < 194) { const int j = c - 128; return so.unit_at(512 + 256 * (j / 22) + SPEC0 + (j % 22), u); }
        return false;
    }
    __device__ __forceinline__ void a_ready(const Unit&) const {}
    __device__ __forceinline__ void done(const Unit&) const {}
};
struct RowUnits {
    int nt; bool have;
    __host__ __device__ bool next(int i, Unit& u) const { if (!have || i >= nt) return false; u.pm = 0; u.pn = i; return true; }
    __device__ __forceinline__ void a_ready(const Unit&) const {}
    __device__ __forceinline__ void done(const Unit&) const {}
};
struct OneUnit {
    int pm = 0, pn; bool have;
    __host__ __device__ bool next(int i, Unit& u) const { if (i != 0 || !have) return false; u.pm = pm; u.pn = pn; return true; }
    __device__ __forceinline__ void a_ready(const Unit&) const {}
    __device__ __forceinline__ void done(const Unit&) const {}
};
__device__ __forceinline__ unsigned cvt_pk_bf16(float lo, float hi) { unsigned r; asm volatile("v_cvt_pk_bf16_f32 %0, %1, %2" : "=v"(r) : "v"(lo), "v"(hi)); return r; }
__device__ __forceinline__ void st_bf16x8(bf16_t* p, const f32x4 a, const f32x4 b) { u32x4 w; w.x = cvt_pk_bf16(a[0], a[1]); w.y = cvt_pk_bf16(a[2], a[3]); w.z = cvt_pk_bf16(b[0], b[1]); w.w = cvt_pk_bf16(b[2], b[3]); *(u32x4*)p = w; }
__device__ __forceinline__ void st_f32x8(float* p, const f32x4 a, const f32x4 b) { *(f32x4*)p = a; *(f32x4*)(p + 4) = b; }

struct EpiIn {
    static constexpr bool PERM = true, AFTER_DRAIN = false;
    const float* ssq; const float* rope;
    bf16_t *QA, *KA, *VA, *QC, *KC, *VC; float* PB;
    float *o_ak_p, *o_av_p, *o_ck_p, *o_cv_p, *o_sh_p, *o_ak_s, *o_av_s, *o_ck_s, *o_cv_s, *o_sh_s;
    template <int TY> __device__ __forceinline__ void run(const f32x4 (&acc)[2][2][4][2], const Unit& u, int wr, int wc, int fr, int fq) const {
        const int pn = u.pn; const bool isS = (u.pm == MP / 256);
        const int cl = wc * 32 + fq * 8;
        float rs[2][4];
#pragma unroll
        for (int ai = 0; ai < 2; ++ai)
#pragma unroll
            for (int m = 0; m < 4; ++m) rs[ai][m] = ssq[u.pm * 256 + ai * 128 + wr * 64 + m * 16 + fr];
#pragma unroll
        for (int ai = 0; ai < 2; ++ai)
#pragma unroll
            for (int m = 0; m < 4; ++m) {
                const int row = u.pm * 256 + ai * 128 + wr * 64 + m * 16 + fr;
                const float rstd = rsqrtf(rs[ai][m] * (1.0f / DM) + RMS_EPS);
                int b, t, pidx;
                if (!isS) { b = row >> 11; t = row & 2047; pidx = t; } else { const int r = row - MP; b = r >> 3; t = r & 7; pidx = SEQ + t; }
#pragma unroll
                for (int bj = 0; bj < 2; ++bj) {
                    f32x4 v0 = acc[ai][bj][m][0] * rstd, v1 = acc[ai][bj][m][1] * rstd;
                    const int c = bj * 128 + cl;
                    const bool roped = (TY == 0 || TY == 1 || TY == 4 || (TY == 5 && bj == 0));
                    if (roped && (wc & 1) == 0) {
                        f32x4 p0, p1;
#pragma unroll
                        for (int j = 0; j < 4; ++j) { p0[j] = __shfl_xor(v0[j], 16); p1[j] = __shfl_xor(v1[j], 16); }
                        const float* rp = rope + pidx * 16;
                        const f32x4 c0 = *(const f32x4*)rp, c1 = *(const f32x4*)(rp + 4), s0 = *(const f32x4*)(rp + 8), s1 = *(const f32x4*)(rp + 12);
                        if (fq == 0) { v0 = v0 * c0 - p0 * s0; v1 = v1 * c1 - p1 * s1; }
                        else if (fq == 1) { v0 = v0 * c0 + p0 * s0; v1 = v1 * c1 + p1 * s1; }
                    }
                    if (TY == 0) { st_bf16x8(QA + (size_t)row * 512 + pn * 256 + c, v0 * QSCALE, v1 * QSCALE); }
                    if (TY == 1) { st_bf16x8(KA + (size_t)row * 512 + (pn - 2) * 256 + c, v0, v1);
                        float* o = (isS ? o_ak_s + (size_t)(row - MP) * 512 : o_ak_p + (size_t)row * 512) + (pn - 2) * 256 + c; st_f32x8(o, v0, v1); }
                    if (TY == 2) { st_bf16x8(VA + (size_t)row * 512 + (pn - 4) * 256 + c, v0, v1);
                        float* o = (isS ? o_av_s + (size_t)(row - MP) * 512 : o_av_p + (size_t)row * 512) + (pn - 4) * 256 + c; st_f32x8(o, v0, v1); }
                    if (TY == 3) { const int cc = (pn - 6) * 256 + c; st_f32x8(PB + (size_t)row * BCOLS + cc, v0, v1);
                        if (!isS && t == SEQ - 1) st_f32x8(o_sh_p + b * BCOLS + cc, v0, v1);
                        if (isS && t == DECS - 1) st_f32x8(o_sh_s + b * BCOLS + cc, v0, v1); }
                    if (TY == 4) { st_bf16x8(QC + (size_t)row * 1024 + (pn - 13) * 256 + c, v0 * QSCALE, v1 * QSCALE); }
                    if (TY == 5) {
                        bf16_t* dst = (bj == 0 ? KC : VC) + (size_t)row * 128 + cl; st_bf16x8(dst, v0, v1);
                        float* op = bj == 0 ? o_ck_p : o_cv_p; float* os = bj == 0 ? o_ck_s : o_cv_s;
                        if (isS) st_f32x8(os + (size_t)(row - MP) * 128 + cl, v0, v1);
                        else if (t >= SEQ - 128) st_f32x8(op + (size_t)(b * 128 + t - (SEQ - 128)) * 128 + cl, v0, v1);
                    }
                }
                asm volatile("" ::: "memory");
            }
    }
    __device__ __forceinline__ void operator()(const f32x4 (&acc)[2][2][4][2], const Unit& u, int wr, int wc, int fr, int fq) const {
        asm volatile("" : "+v"(fr), "+v"(fq));
        const int pn = u.pn;
        if (pn < 2) run<0>(acc, u, wr, wc, fr, fq);
        else if (pn < 4) run<1>(acc, u, wr, wc, fr, fq);
        else if (pn < 6) run<2>(acc, u, wr, wc, fr, fq);
        else if (pn < 13) run<3>(acc, u, wr, wc, fr, fq);
        else if (pn < 17) run<4>(acc, u, wr, wc, fr, fq);
        else run<5>(acc, u, wr, wc, fr, fq);
        asm volatile("s_waitcnt vmcnt(0)" ::: "memory");
    }
};
struct EpiRes {
    static constexpr bool PERM = true, AFTER_DRAIN = false;
    float* X; const float* Xin; bf16_t* XN; float* ssq_next; int dry;
    __device__ __forceinline__ void operator()(const f32x4 (&acc)[2][2][4][2], const Unit& u, int wr, int wc, int fr, int fq) const {
        asm volatile("" : "+v"(fr), "+v"(fq));
        const int cl = u.pn * 256 + wc * 32 + fq * 8;
        f32x4 xc[2][2], xn[2][2];
        { const float* xp = Xin + (size_t)(u.pm * 256 + wr * 64 + fr) * DM + cl;
          xc[0][0] = *(const f32x4*)xp; xc[0][1] = *(const f32x4*)(xp + 4); xc[1][0] = *(const f32x4*)(xp + 128); xc[1][1] = *(const f32x4*)(xp + 132); }
        xn[0][0] = xn[0][1] = xn[1][0] = xn[1][1] = (f32x4){0.f, 0.f, 0.f, 0.f};
#pragma unroll
        for (int ai = 0; ai < 2; ++ai)
#pragma unroll
            for (int m = 0; m < 4; ++m) {
                const int row = u.pm * 256 + ai * 128 + wr * 64 + m * 16 + fr; float s = 0.f;
                if (!(ai == 1 && m == 3)) { const int g1 = ai * 4 + m + 1; const float* xp = Xin + (size_t)(u.pm * 256 + (g1 >> 2) * 128 + wr * 64 + (g1 & 3) * 16 + fr) * DM + cl;
                    xn[0][0] = *(const f32x4*)xp; xn[0][1] = *(const f32x4*)(xp + 4); xn[1][0] = *(const f32x4*)(xp + 128); xn[1][1] = *(const f32x4*)(xp + 132); }
#pragma unroll
                for (int bj = 0; bj < 2; ++bj) {
                    float* xp = X + (size_t)row * DM + cl + bj * 128;
                    const f32x4 x0 = xc[bj][0] + acc[ai][bj][m][0], x1 = xc[bj][1] + acc[ai][bj][m][1];
                    if (!dry) { st_f32x8(xp, x0, x1); st_bf16x8(XN + (size_t)row * DM + cl + bj * 128, x0, x1); }
                    s += (x0[0] * x0[0] + x0[1] * x0[1]) + (x0[2] * x0[2] + x0[3] * x0[3]) + (x1[0] * x1[0] + x1[1] * x1[1]) + (x1[2] * x1[2] + x1[3] * x1[3]);
                }
                s += __shfl_xor(s, 16); s += __shfl_xor(s, 32);
                if (fq == 0 && !dry) unsafeAtomicAdd(ssq_next + row, s);
                asm volatile("" ::: "memory");
                xc[0][0] = xn[0][0]; xc[0][1] = xn[0][1]; xc[1][0] = xn[1][0]; xc[1][1] = xn[1][1];
            }
    }
};
struct EpiFinal {
    static constexpr bool PERM = true, AFTER_DRAIN = true;
    const float* X; float* OUT; const float* gf; float* ssq; unsigned* cnt;
    __device__ __forceinline__ void fused(const f32x4 (&acc)[2][2][4][2], const Unit& u, int wr, int wc, int fr, int fq, PG8_LAS unsigned char*, int wid, int lane) const {
        asm volatile("" : "+v"(fr), "+v"(fq));
        const int cl = u.pn * 256 + wc * 32 + fq * 8;
        f32x4 xv[2][4][2][2];
        f32x4 xc[2][2], xn[2][2];
        { const float* xp = X + (size_t)(u.pm * 256 + wr * 64 + fr) * DM + cl;
          xc[0][0] = *(const f32x4*)xp; xc[0][1] = *(const f32x4*)(xp + 4); xc[1][0] = *(const f32x4*)(xp + 128); xc[1][1] = *(const f32x4*)(xp + 132); }
        xn[0][0] = xn[0][1] = xn[1][0] = xn[1][1] = (f32x4){0.f, 0.f, 0.f, 0.f};
#pragma unroll
        for (int ai = 0; ai < 2; ++ai)
#pragma unroll
            for (int m = 0; m < 4; ++m) {
                const int row = u.pm * 256 + ai * 128 + wr * 64 + m * 16 + fr; float s = 0.f;
                if (!(ai == 1 && m == 3)) { const int g1 = ai * 4 + m + 1; const float* xp = X + (size_t)(u.pm * 256 + (g1 >> 2) * 128 + wr * 64 + (g1 & 3) * 16 + fr) * DM + cl;
                    xn[0][0] = *(const f32x4*)xp; xn[0][1] = *(const f32x4*)(xp + 4); xn[1][0] = *(const f32x4*)(xp + 128); xn[1][1] = *(const f32x4*)(xp + 132); }
#pragma unroll
                for (int bj = 0; bj < 2; ++bj) {
                    const f32x4 x0 = xc[bj][0] + acc[ai][bj][m][0], x1 = xc[bj][1] + acc[ai][bj][m][1];
                    xv[ai][m][bj][0] = x0; xv[ai][m][bj][1] = x1;
                    s += (x0[0] * x0[0] + x0[1] * x0[1]) + (x0[2] * x0[2] + x0[3] * x0[3]) + (x1[0] * x1[0] + x1[1] * x1[1]) + (x1[2] * x1[2] + x1[3] * x1[3]);
                }
                s += __shfl_xor(s, 16); s += __shfl_xor(s, 32);
                if (fq == 0) (void)__hip_atomic_fetch_add(ssq + row, s, __ATOMIC_RELAXED, __HIP_MEMORY_SCOPE_AGENT);
                asm volatile("" ::: "memory");
                xc[0][0] = xn[0][0]; xc[0][1] = xn[0][1]; xc[1][0] = xn[1][0]; xc[1][1] = xn[1][1];
            }
        asm volatile("s_waitcnt vmcnt(0)" ::: "memory");
        __syncthreads();
        if (wid == 0 && lane == 0) {
            unsigned long long ci_ = (unsigned long long)(cnt + u.pm * 32); asm volatile("" : "+v"(ci_)); unsigned* cp = (unsigned*)(__attribute__((address_space(1))) unsigned*)ci_;
            (void)__hip_atomic_fetch_add(cp, 1u, __ATOMIC_RELAXED, __HIP_MEMORY_SCOPE_AGENT);
            unsigned sp = 0; while (__hip_atomic_load(cp, __ATOMIC_RELAXED, __HIP_MEMORY_SCOPE_AGENT) < 8u) { __builtin_amdgcn_s_sleep(1); if (++sp > (1u << 22)) break; }
        }
        __syncthreads();
        float rs[2][4];
#pragma unroll
        for (int ai = 0; ai < 2; ++ai)
#pragma unroll
            for (int m = 0; m < 4; ++m) rs[ai][m] = __hip_atomic_load(ssq + u.pm * 256 + ai * 128 + wr * 64 + m * 16 + fr, __ATOMIC_RELAXED, __HIP_MEMORY_SCOPE_AGENT);
        f32x4 gg[2][2];
#pragma unroll
        for (int bj = 0; bj < 2; ++bj) { gg[bj][0] = *(const f32x4*)(gf + cl + bj * 128); gg[bj][1] = *(const f32x4*)(gf + cl + bj * 128 + 4); }
#pragma unroll
        for (int ai = 0; ai < 2; ++ai)
#pragma unroll
            for (int m = 0; m < 4; ++m) {
                const int row = u.pm * 256 + ai * 128 + wr * 64 + m * 16 + fr;
                const float rstd = rsqrtf(rs[ai][m] * (1.0f / DM) + RMS_EPS);
#pragma unroll
                for (int bj = 0; bj < 2; ++bj) st_f32x8(OUT + (size_t)row * DM + cl + bj * 128, xv[ai][m][bj][0] * rstd * gg[bj][0], xv[ai][m][bj][1] * rstd * gg[bj][1]);
                asm volatile("" ::: "memory");
            }
    }
};
struct EpiPart {
    static constexpr bool PERM = true, AFTER_DRAIN = false;
    float* P;
    __device__ __forceinline__ void operator()(const f32x4 (&acc)[2][2][4][2], const Unit& u, int wr, int wc, int fr, int fq) const {
        asm volatile("" : "+v"(fr), "+v"(fq));
        const int cl = u.pn * 256 + wc * 32 + fq * 8;
#pragma unroll
        for (int ai = 0; ai < 2; ++ai)
#pragma unroll
            for (int m = 0; m < 4; ++m) {
                const int row = ai * 128 + wr * 64 + m * 16 + fr;
#pragma unroll
                for (int bj = 0; bj < 2; ++bj) st_f32x8(P + (size_t)row * DM + cl + bj * 128, acc[ai][bj][m][0], acc[ai][bj][m][1]);
            }
    }
};
struct EpiGU {
    static constexpr bool PERM = true, AFTER_DRAIN = false;
    const float* ssq; bf16_t* ACT;
    __device__ __forceinline__ void operator()(const f32x4 (&acc)[2][2][4][2], const Unit& u, int wr, int wc, int fr, int fq) const {
        asm volatile("" : "+v"(fr), "+v"(fq));
        const int cl = u.pn * 128 + wc * 32 + fq * 8;
        float rs[2][4];
#pragma unroll
        for (int ai = 0; ai < 2; ++ai)
#pragma unroll
            for (int m = 0; m < 4; ++m) rs[ai][m] = ssq[u.pm * 256 + ai * 128 + wr * 64 + m * 16 + fr];
#pragma unroll
        for (int ai = 0; ai < 2; ++ai)
#pragma unroll
            for (int m = 0; m < 4; ++m) {
                const int row = u.pm * 256 + ai * 128 + wr * 64 + m * 16 + fr;
                const float rstd = rsqrtf(rs[ai][m] * (1.0f / DM) + RMS_EPS);
                f32x4 o[2];
#pragma unroll
                for (int n = 0; n < 2; ++n) {
                    const f32x4 g = acc[ai][0][m][n] * rstd, up = acc[ai][1][m][n] * rstd;
#pragma unroll
                    for (int j = 0; j < 4; ++j) o[n][j] = g[j] * __builtin_amdgcn_rcpf(1.0f + __builtin_amdgcn_exp2f(-1.4426950408889634f * g[j])) * up[j];
                }
                st_bf16x8(ACT + (size_t)row * FF + cl, o[0], o[1]);
                asm volatile("" ::: "memory");
            }
    }
};

template <class Epi, class Sched, bool ALIGN_EPI = false, bool SP2 = false>
__device__ __forceinline__ void gemm_phase(PG8_LAS unsigned char* lds, const Gemm g, const Sched& S, const Epi& E, const int wave_id) {
    int lane_; asm volatile("v_mbcnt_lo_u32_b32 %0, -1, 0\n\tv_mbcnt_hi_u32_b32 %0, -1, %0" : "=v"(lane_));
    const int wid = wave_id, lane = lane_, tid = wid * 64 + lane, wr = wid >> 2, wc = wid & 3, fr = lane & 15, fq = lane >> 4;
    const int K = g.K, nt = K / BK;
    unsigned voffA[2], voffB[2];
#pragma unroll
    for (int i = 0; i < 2; ++i) { int R, C; stage_rc(tid * 16 + i * 8192, R, C); const int Rb = Epi::PERM ? ((R & ~31) + perm32(R & 31)) : R;
        voffA[i] = (unsigned)(R * g.ld + C) * 2u; voffB[i] = (unsigned)(Rb * g.ld + C) * 2u; }
    const size_t kstep = (size_t)(BK * 2);
    const size_t hstep = (size_t)HALF * g.ld * 2;
    const size_t tstep = 2 * hstep;
    const unsigned ldsw = (unsigned)wid * 1024u;
    const int aoff = lds_byte(wr * 64 + fr, fq * 8), boff = lds_byte(wc * 32 + fr, fq * 8);
#define PG8_SA(b, h) (((b) * 2 + (h)) * HTB)
#define PG8_SB(b, h) ((4 + (b) * 2 + (h)) * HTB)
#define PG8_STAGE(bufoff, gbase, voff) do { _Pragma("unroll") for (int _i = 0; _i < 2; ++_i) \
        __builtin_amdgcn_global_load_lds((const unsigned*)((const char*)(gbase) + (voff)[_i]), (PG8_LAS unsigned*)(lds + (bufoff) + ldsw + _i * 8192), 16, 0, 0); } while (0)
#define PG8_LDA(dst, b, h) do { _Pragma("unroll") for (int m = 0; m < 4; ++m) _Pragma("unroll") for (int k = 0; k < 2; ++k) dst[m][k] = *(const PG8_LAS bf16x8*)(lds + PG8_SA(b, h) + aoff + m * 2048 + k * 1024); } while (0)
#define PG8_LDB(dst, b, h) do { _Pragma("unroll") for (int n = 0; n < 2; ++n) _Pragma("unroll") for (int k = 0; k < 2; ++k) dst[n][k] = *(const PG8_LAS bf16x8*)(lds + PG8_SB(b, h) + boff + n * 2048 + k * 1024); } while (0)
#define PG8_MMA(ai, bj, At, Bt) do { __builtin_amdgcn_s_setprio(1); _Pragma("unroll") for (int m = 0; m < 4; ++m) _Pragma("unroll") for (int n = 0; n < 2; ++n) _Pragma("unroll") for (int k = 0; k < 2; ++k) \
        acc[ai][bj][m][n] = __builtin_amdgcn_mfma_f32_16x16x32_bf16(Bt[n][k], At[m][k], acc[ai][bj][m][n], 0, 0, 0); __builtin_amdgcn_s_setprio(0); } while (0)
#define PG8_WAIT_V(n) asm volatile("s_waitcnt vmcnt(" #n ")" ::: "memory")
#define PG8_WAIT_L(n) asm volatile("s_waitcnt lgkmcnt(" #n ")" ::: "memory")
#define PG8_BAR __builtin_amdgcn_s_barrier()
#define PG8_SCHED __builtin_amdgcn_sched_barrier(0)
    Unit cur, nxt; int ui = 0;
    if (!S.next(0, cur)) return;
    f32x4 acc[2][2][4][2];
#pragma unroll
    for (int a = 0; a < 2; ++a)
#pragma unroll
        for (int b = 0; b < 2; ++b)
#pragma unroll
            for (int m = 0; m < 4; ++m)
#pragma unroll
                for (int n = 0; n < 2; ++n) acc[a][b][m][n] = (f32x4){0.f, 0.f, 0.f, 0.f};
    bf16x8 At[4][2], B0[2][2], B1[2][2];
    const char* cA = (const char*)g.A + (size_t)cur.pm * tstep; const char* cB = (const char*)g.Bt + (size_t)cur.pn * tstep;
    S.a_ready(cur);
    if constexpr (SP2) {
        PG8_STAGE(PG8_SB(0, 0), cB, voffB); PG8_STAGE(PG8_SB(0, 1), cB + hstep, voffB); PG8_STAGE(PG8_SA(0, 0), cA, voffA); PG8_STAGE(PG8_SA(0, 1), cA + hstep, voffA);
        if (wr == 1) PG8_BAR;
        PG8_WAIT_V(2); PG8_BAR;
        PG8_STAGE(PG8_SB(1, 0), cB + kstep, voffB); PG8_STAGE(PG8_SA(1, 0), cA + kstep, voffA); PG8_STAGE(PG8_SB(1, 1), cB + hstep + kstep, voffB);
        PG8_WAIT_V(6); PG8_BAR;
    } else {
        PG8_STAGE(PG8_SB(0, 0), cB, voffB); PG8_STAGE(PG8_SA(0, 0), cA, voffA); PG8_STAGE(PG8_SB(0, 1), cB + hstep, voffB); PG8_STAGE(PG8_SA(0, 1), cA + hstep, voffA);
        if (wr == 1) PG8_BAR;
        PG8_WAIT_V(4); PG8_BAR;
        PG8_STAGE(PG8_SB(1, 0), cB + kstep, voffB); PG8_STAGE(PG8_SA(1, 0), cA + kstep, voffA); PG8_STAGE(PG8_SB(1, 1), cB + hstep + kstep, voffB);
        PG8_WAIT_V(6); PG8_BAR;
    }
    for (;;) {
        const bool has_next = S.next(ui + 1, nxt);
        const char* nA = has_next ? (const char*)g.A + (size_t)nxt.pm * tstep : cA; const char* nB = has_next ? (const char*)g.Bt + (size_t)nxt.pn * tstep : cB;
        for (int t = 0; t < nt; t += 2) {
            const bool last = (t == nt - 2);
            const char* a1 = cA + (size_t)(t + 1) * kstep;
            const char* a2 = last ? nA : cA + (size_t)(t + 2) * kstep; const char* b2 = last ? nB : cB + (size_t)(t + 2) * kstep;
            const char* a3 = a2 + kstep; const char* b3 = b2 + kstep;
            if (last && has_next) S.a_ready(nxt);
            if constexpr (SP2) {
            PG8_LDB(B0, 0, 0); PG8_LDB(B1, 0, 1); PG8_SCHED; PG8_LDA(At, 0, 0); PG8_STAGE(PG8_SA(1, 1), a1 + hstep, voffA);
            PG8_WAIT_V(8); PG8_WAIT_L(0); PG8_BAR; PG8_MMA(0, 0, At, B0); PG8_MMA(0, 1, At, B1); PG8_BAR; PG8_SCHED;
            PG8_LDA(At, 0, 1); PG8_STAGE(PG8_SB(0, 0), b2, voffB); PG8_STAGE(PG8_SB(0, 1), b2 + hstep, voffB); PG8_STAGE(PG8_SA(0, 0), a2, voffA);
            PG8_WAIT_V(8); PG8_WAIT_L(0); PG8_BAR; PG8_MMA(1, 0, At, B0); PG8_MMA(1, 1, At, B1); PG8_BAR; PG8_SCHED;
            PG8_LDB(B0, 1, 0); PG8_LDB(B1, 1, 1); PG8_SCHED; PG8_LDA(At, 1, 0); PG8_STAGE(PG8_SA(0, 1), a2 + hstep, voffA);
            PG8_WAIT_V(8); PG8_WAIT_L(0); PG8_BAR; PG8_MMA(0, 0, At, B0); PG8_MMA(0, 1, At, B1); PG8_BAR; PG8_SCHED;
            PG8_LDA(At, 1, 1); PG8_STAGE(PG8_SB(1, 0), b3, voffB); PG8_STAGE(PG8_SB(1, 1), b3 + hstep, voffB); PG8_STAGE(PG8_SA(1, 0), a3, voffA);
            PG8_WAIT_V(8); PG8_WAIT_L(0); PG8_BAR; PG8_MMA(1, 0, At, B0); PG8_MMA(1, 1, At, B1); PG8_BAR; PG8_SCHED;
            } else {
            PG8_LDB(B0, 0, 0); PG8_SCHED; PG8_LDA(At, 0, 0); PG8_STAGE(PG8_SA(1, 1), a1 + hstep, voffA);
            PG8_WAIT_L(8); PG8_BAR; PG8_WAIT_L(0); PG8_MMA(0, 0, At, B0); PG8_BAR; PG8_SCHED;
            PG8_LDB(B1, 0, 1); PG8_STAGE(PG8_SB(0, 0), b2, voffB);
            PG8_BAR; PG8_WAIT_L(0); PG8_MMA(0, 1, At, B1); PG8_BAR;
            PG8_LDA(At, 0, 1); PG8_STAGE(PG8_SA(0, 0), a2, voffA);
            PG8_BAR; PG8_WAIT_L(0); PG8_MMA(1, 0, At, B0); PG8_BAR; PG8_SCHED;
            PG8_STAGE(PG8_SB(0, 1), b2 + hstep, voffB);
            PG8_WAIT_V(6); PG8_BAR; PG8_MMA(1, 1, At, B1); PG8_BAR;
            PG8_LDB(B0, 1, 0); PG8_SCHED; PG8_LDA(At, 1, 0); PG8_STAGE(PG8_SA(0, 1), a2 + hstep, voffA);
            PG8_WAIT_L(8); PG8_BAR; PG8_WAIT_L(0); PG8_MMA(0, 0, At, B0); PG8_BAR; PG8_SCHED;
            PG8_LDB(B1, 1, 1); PG8_STAGE(PG8_SB(1, 0), b3, voffB);
            PG8_BAR; PG8_WAIT_L(0); PG8_MMA(0, 1, At, B1); PG8_BAR;
            PG8_LDA(At, 1, 1); PG8_STAGE(PG8_SA(1, 0), a3, voffA);
            PG8_BAR; PG8_WAIT_L(0); PG8_MMA(1, 0, At, B0); PG8_BAR; PG8_SCHED;
            PG8_STAGE(PG8_SB(1, 1), b3 + hstep, voffB);
            PG8_WAIT_V(6); PG8_BAR; PG8_MMA(1, 1, At, B1); PG8_BAR;
            }
        }
        if constexpr (ALIGN_EPI) { if (wr == 0) PG8_BAR; }
        if constexpr (!Epi::AFTER_DRAIN) { E(acc, cur, wr, wc, fr, fq); S.done(cur); }
        if (!has_next) break;
#pragma unroll
        for (int a = 0; a < 2; ++a)
#pragma unroll
            for (int b = 0; b < 2; ++b)
#pragma unroll
                for (int m = 0; m < 4; ++m)
#pragma unroll
                    for (int n = 0; n < 2; ++n) acc[a][b][m][n] = (f32x4){0.f, 0.f, 0.f, 0.f};
        cur = nxt; cA = nA; cB = nB; ++ui;
        if constexpr (ALIGN_EPI) { if (wr == 1) PG8_BAR; }
    }
    PG8_WAIT_V(0);
    if constexpr (!ALIGN_EPI) { if (wr == 0) PG8_BAR; }
    PG8_BAR;
    if constexpr (Epi::AFTER_DRAIN) { E.fused(acc, cur, wr, wc, fr, fq, lds, wid, lane); S.done(cur); }
#undef PG8_SA
#undef PG8_SB
#undef PG8_STAGE
#undef PG8_LDA
#undef PG8_LDB
#undef PG8_MMA
#undef PG8_WAIT_V
#undef PG8_WAIT_L
#undef PG8_BAR
#undef PG8_SCHED
}
}

#define LAS __attribute__((address_space(3)))
typedef unsigned short bf16_t;
typedef unsigned u32x4 __attribute__((ext_vector_type(4)));
typedef unsigned u32x2 __attribute__((ext_vector_type(2)));
typedef float f32x4 __attribute__((ext_vector_type(4)));
typedef float f32x2 __attribute__((ext_vector_type(2)));
typedef short bf16x8 __attribute__((ext_vector_type(8)));
typedef short bf16x4 __attribute__((ext_vector_type(4)));
#define LDS_WAIT() asm volatile("s_waitcnt lgkmcnt(0)" ::: "memory")
__device__ __forceinline__ unsigned f2bf(float f) { unsigned u = __builtin_bit_cast(unsigned, f); return (u + 0x7fffu + ((u >> 16) & 1u)) >> 16; }
__device__ __forceinline__ unsigned pk2(float lo, float hi) { unsigned r; asm("v_cvt_pk_bf16_f32 %0, %1, %2" : "=v"(r) : "v"(lo), "v"(hi)); return r; }
__device__ __forceinline__ float bf2f(unsigned short h) { return __builtin_bit_cast(float, (unsigned)h << 16); }
__device__ __forceinline__ float dppf(float v, const int ctrl) { return v; }
#define DPP_ADD(v, ctrl) ((v) + __builtin_bit_cast(float, __builtin_amdgcn_mov_dpp(__builtin_bit_cast(int, (v)), (ctrl), 0xF, 0xF, true)))
__device__ __forceinline__ float row16_sum(float v) {
    v = DPP_ADD(v, 0xB1);
    v = DPP_ADD(v, 0x4E);
    v = DPP_ADD(v, 0x141);
    v = DPP_ADD(v, 0x140);
    return v;
}
__device__ __forceinline__ float wave_sum(float v) {
    const int iv = __builtin_bit_cast(int, row16_sum(v));
    const float a = __builtin_bit_cast(float, __builtin_amdgcn_readlane(iv, 0)), b = __builtin_bit_cast(float, __builtin_amdgcn_readlane(iv, 16));
    const float c = __builtin_bit_cast(float, __builtin_amdgcn_readlane(iv, 32)), d = __builtin_bit_cast(float, __builtin_amdgcn_readlane(iv, 48));
    return (a + b) + (c + d);
}
__device__ __forceinline__ float sigmoidf_(float x) { return __builtin_amdgcn_rcpf(1.0f + __builtin_amdgcn_exp2f(-1.4426950408889634f * x)); }
__device__ __forceinline__ float tanhf_(float x) { return 1.0f - 2.0f * __builtin_amdgcn_rcpf(1.0f + __builtin_amdgcn_exp2f(2.8853900817779268f * x)); }

#define XB_TMO      128
#define XB_XCNT(j)  (256  + 64 * (j))
#define XB_XSUB(j)  (1280 + 64 * (j))
#define XB_XGEN(j)  (2304 + 64 * (j))
#define XB_TOP      3328
#define XB_TOPGEN   3392
#define XCD_BAR_WORDS 3456
#define XB_SPIN_CAP (1u << 18)

__device__ __forceinline__ unsigned xb_ld(unsigned* p)              { return __hip_atomic_load(p, __ATOMIC_RELAXED, __HIP_MEMORY_SCOPE_AGENT); }
__device__ __forceinline__ unsigned xb_add(unsigned* p, unsigned v) { return __hip_atomic_fetch_add(p, v, __ATOMIC_RELAXED, __HIP_MEMORY_SCOPE_AGENT); }
__device__ __forceinline__ unsigned xb_xcc_id() { return (unsigned)__builtin_amdgcn_s_getreg((3 << 11) | 20) & 0xFu; }
#define XB_SPIN(cond, bar) do { unsigned _sp = 0; while (cond) { __builtin_amdgcn_s_sleep(1); \
    if ((++_sp & 255u) == 0u) { if (xb_ld(&(bar)[XB_TMO])) break; if (_sp > XB_SPIN_CAP) { atomicAdd(&(bar)[XB_TMO], 1u); break; } } } } while (0)

struct XcdBarrier {
    unsigned* bar; unsigned x;
    volatile LAS unsigned* st;
};

__device__ __forceinline__ XcdBarrier xcd_barrier_post(unsigned* bar, volatile LAS unsigned* st) {
    XcdBarrier b; b.bar = bar; b.x = xb_xcc_id(); b.st = st;
    if (threadIdx.x == 0) (void)xb_add(&bar[XB_XCNT(b.x)], 1u);
    return b;
}
__device__ __forceinline__ void xcd_barrier_complete(unsigned* bar, unsigned x, unsigned& nloc, unsigned& nx) {
    const unsigned G = gridDim.x * gridDim.y * gridDim.z;
    unsigned sum, cnt, mine, sp = 0u;
    for (;;) {
        sum = 0u; cnt = 0u; mine = 0u;
#pragma unroll
        for (unsigned j = 0; j < 16; ++j) { const unsigned c = xb_ld(&bar[XB_XCNT(j)]); sum += c; cnt += (c > 0u) ? 1u : 0u; mine = (j == x) ? c : mine; }
        if (sum == G) break;
        __builtin_amdgcn_s_sleep(1);
        if ((++sp & 255u) == 0u) { if (xb_ld(&bar[XB_TMO])) break; if (sp > XB_SPIN_CAP) { atomicAdd(&bar[XB_TMO], 1u); break; } }
    }
    nloc = mine > 0u ? mine : 1u; nx = cnt > 0u ? cnt : 1u;
}

__device__ __forceinline__ void xcd_barrier(const XcdBarrier& b, const bool is_t0) {
    asm volatile("s_waitcnt vmcnt(0)" ::: "memory");
    __syncthreads();
    if (is_t0) {
        unsigned long long bi_ = (unsigned long long)b.bar; asm volatile("" : "+v"(bi_)); unsigned* bar = (unsigned*)(__attribute__((address_space(1))) unsigned*)bi_;
        __builtin_amdgcn_s_waitcnt(0);
        unsigned nloc = b.st[0], nx = b.st[1];
        if (nloc == 0u) { xcd_barrier_complete(bar, b.x, nloc, nx); b.st[0] = nloc; b.st[1] = nx; }
        const unsigned old = xb_add(&bar[XB_XSUB(b.x)], 1u);
        const unsigned gen = old / nloc;
        if (old + 1u == (gen + 1u) * nloc) {
            __builtin_amdgcn_fence(__ATOMIC_RELEASE, "agent");
            asm volatile("s_waitcnt vmcnt(0)" ::: "memory");
            const unsigned og = xb_add(&bar[XB_TOP], 1u);
            const unsigned tg = og / nx;
            if (og + 1u == (tg + 1u) * nx) xb_add(&bar[XB_TOPGEN], 1u);
            else XB_SPIN(xb_ld(&bar[XB_TOPGEN]) == tg, bar);
            __builtin_amdgcn_fence(__ATOMIC_ACQUIRE, "agent");
            xb_add(&bar[XB_XGEN(b.x)], 1u);
            asm volatile("s_waitcnt vmcnt(0)" ::: "memory");
        } else {
            XB_SPIN(xb_ld(&bar[XB_XGEN(b.x)]) == gen, bar);
            __builtin_amdgcn_fence(__ATOMIC_ACQUIRE, "agent");
            asm volatile("s_waitcnt vmcnt(0)" ::: "memory");
        }
    }
    __syncthreads();
}

constexpr size_t MiB = 1u << 20;
constexpr size_t al1(size_t x) { return (x + MiB - 1) / MiB * MiB; }
constexpr size_t WS_CTL = 0, CTL_ZERO_BYTES = 2 * MiB;
constexpr int CW_BAR = 4096, CW_FIN = 16384;
constexpr size_t SSQ_OFF = 256 * 1024;
constexpr size_t WS_ROPE = WS_CTL + CTL_ZERO_BYTES;
constexpr size_t WS_WLT = WS_ROPE + al1(2056 * 16 * 4);
constexpr size_t WS_X = WS_WLT + al1((size_t)DEPTH * 3 * 512 * 96 * 2);
constexpr size_t WS_XN = WS_X + al1((size_t)MTOT * DM * 4);
constexpr size_t WS_QA = WS_XN + al1((size_t)MTOT * DM * 2);
constexpr size_t WS_KA = WS_QA + al1((size_t)MTOT * 512 * 2);
constexpr size_t WS_VA = WS_KA + al1((size_t)MTOT * 512 * 2);
constexpr size_t WS_PB = WS_VA + al1((size_t)MTOT * 512 * 2);
constexpr size_t WS_QC = WS_PB + al1((size_t)MTOT * BCOLS * 4);
constexpr size_t WS_KC = WS_QC + al1((size_t)MTOT * 1024 * 2);
constexpr size_t WS_VC = WS_KC + al1((size_t)MTOT * 128 * 2);
constexpr size_t WS_MIX = WS_VC + al1((size_t)MTOT * 128 * 2);
constexpr size_t WS_ACT = WS_MIX + al1((size_t)MTOT * DM * 2);
constexpr size_t WS_OA = WS_ACT + al1((size_t)MTOT * FF * 2);
constexpr size_t WS_LSE = WS_OA + al1((size_t)3 * MP * 512 * 4);
constexpr int NTH = MP * 8 + MS * 8;
constexpr size_t WS_OPS = WS_LSE + al1((size_t)3 * MP * 8 * 4);
constexpr size_t WS_GG = WS_OPS + al1((size_t)NTH * 6 * 64 * 4);
constexpr size_t WS_BON = WS_GG + al1((size_t)NTH * 64 * 4);
constexpr size_t WS_YZ = WS_BON + al1((size_t)NTH * 4);
constexpr size_t WS_YS = WS_YZ + al1((size_t)MP * 8 * 128 * 4);
constexpr size_t WS_ENDS = WS_YS + al1((size_t)MS * 8 * 64 * 4);
constexpr size_t WS_PART = WS_ENDS + al1((size_t)256 * 2 * 4096 * 4);
constexpr size_t WS_WIN = WS_PART + al1((size_t)22 * MS * DM * 4);
constexpr size_t WS_WOUT = WS_WIN + al1((size_t)DEPTH * INC * DM * 2);
constexpr size_t WS_WGU = WS_WOUT + al1((size_t)DEPTH * DM * DM * 2);
constexpr size_t WS_WDN = WS_WGU + al1((size_t)DEPTH * NGU * DM * 2);
constexpr size_t WS_END = WS_WDN + al1((size_t)DEPTH * DM * FF * 2);

constexpr size_t O_YP = 0, O_YS = O_YP + (size_t)MP * DM, O_AKP = O_YS + (size_t)MS * DM, O_AVP = O_AKP + (size_t)DEPTH * MP * 512, O_CKP = O_AVP + (size_t)DEPTH * MP * 512,
    O_CVP = O_CKP + (size_t)DEPTH * NBATCH * 128 * 128, O_WKVP = O_CVP + (size_t)DEPTH * NBATCH * 128 * 128, O_SHP = O_WKVP + (size_t)DEPTH * NBATCH * 8 * 4096,
    O_AKS = O_SHP + (size_t)DEPTH * NBATCH * BCOLS, O_AVS = O_AKS + (size_t)DEPTH * MS * 512, O_CKS = O_AVS + (size_t)DEPTH * MS * 512, O_CVS = O_CKS + (size_t)DEPTH * MS * 128,
    O_WKVS = O_CVS + (size_t)DEPTH * MS * 128, O_SHS = O_WKVS + (size_t)DEPTH * DECB * 8 * 4096, O_END = O_SHS + (size_t)DEPTH * DECB * BCOLS;

constexpr int RING_BYTES = 139264, MISC_OFF = RING_BYTES + 320, LDS_BYTES = 147456;

constexpr int P0_TS = 136;
__device__ __forceinline__ void p0_item(const float* W, int K, int N, bf16_t* WT, const float* gk, int mode, LAS unsigned char* scr, int item, int lane) {
    const int nblk = N / 64, kb = item / nblk, nb = item % nblk, k0 = 64 * kb, n0 = 64 * nb;
    const int nq = lane & 15, kq = lane >> 4;
    const float* wp = W + (size_t)(k0 + 16 * kq) * N + n0 + 4 * nq;
    f32x4 v[16];
#pragma unroll
    for (int i = 0; i < 16; ++i) v[i] = *(const f32x4*)(wp + (size_t)i * N);
    if (gk) {
        const f32x4 g0 = *(const f32x4*)(gk + k0 + 16 * kq), g1 = *(const f32x4*)(gk + k0 + 16 * kq + 4), g2 = *(const f32x4*)(gk + k0 + 16 * kq + 8), g3 = *(const f32x4*)(gk + k0 + 16 * kq + 12);
#pragma unroll
        for (int i = 0; i < 4; ++i) { v[i] = v[i] * g0[i]; v[4 + i] = v[4 + i] * g1[i]; v[8 + i] = v[8 + i] * g2[i]; v[12 + i] = v[12 + i] * g3[i]; }
    }
#pragma unroll
    for (int j = 0; j < 4; ++j) {
        u32x4 a, b;
        a.x = pk2(v[0][j], v[1][j]); a.y = pk2(v[2][j], v[3][j]); a.z = pk2(v[4][j], v[5][j]); a.w = pk2(v[6][j], v[7][j]);
        b.x = pk2(v[8][j], v[9][j]); b.y = pk2(v[10][j], v[11][j]); b.z = pk2(v[12][j], v[13][j]); b.w = pk2(v[14][j], v[15][j]);
        LAS unsigned char* t = scr + (4 * nq + j) * P0_TS + 32 * kq;
        *(LAS u32x4*)t = a; *(LAS u32x4*)(t + 16) = b;
    }
    LDS_WAIT(); asm volatile("" ::: "memory");
    const int c = lane & 7;
#pragma unroll
    for (int it = 0; it < 8; ++it) {
        const int n = (lane >> 3) + 8 * it;
        const u32x4 o = *(const LAS u32x4*)(scr + n * P0_TS + 16 * c);
        const int nn = n0 + n; const int orow = mode == 0 ? nn : (256 * (nn >> 7) + (nn & 127) + (mode == 2 ? 128 : 0));
        *(u32x4*)(WT + (size_t)orow * K + k0 + 8 * c) = o;
    }
    LDS_WAIT(); asm volatile("" ::: "memory");
}

constexpr int IT_IN = (DM / 64) * (INC / 64), IT_OUT = (DM / 64) * (DM / 64), IT_G = (DM / 64) * (FF / 64), IT_D = (FF / 64) * (DM / 64), IT_A = IT_IN + IT_OUT + IT_D, IT_B = 2 * IT_G;
#define CONV_ITEM_A(ly, r_) do { int r = (r_); \
    if (r < IT_IN) { p0_item(IN(I_WIN) + (size_t)(ly) * DM * INC, DM, INC, G_WIN + (size_t)(ly) * INC * DM, IN(I_GMIX) + (ly) * DM, 0, scr, r, lane); break; } r -= IT_IN; \
    if (r < IT_OUT) { p0_item(IN(I_WOUT) + (size_t)(ly) * DM * DM, DM, DM, G_WOUT + (size_t)(ly) * DM * DM, nullptr, 0, scr, r, lane); break; } r -= IT_OUT; \
    p0_item(IN(I_WD) + (size_t)(ly) * FF * DM, FF, DM, G_WDN + (size_t)(ly) * DM * FF, nullptr, 0, scr, r, lane); } while (0)
#define CONV_ITEM_B(ly, r_) do { int r = (r_); \
    if (r < IT_G) { p0_item(IN(I_WG) + (size_t)(ly) * DM * FF, DM, FF, G_WGU + (size_t)(ly) * NGU * DM, IN(I_GFFN) + (ly) * DM, 1, scr, r, lane); break; } r -= IT_G; \
    p0_item(IN(I_WU) + (size_t)(ly) * DM * FF, DM, FF, G_WGU + (size_t)(ly) * NGU * DM, IN(I_GFFN) + (ly) * DM, 2, scr, r, lane); } while (0)

constexpr int KS_STRIDE = 144, KS_BYTES = 256 * KS_STRIDE, VT_OFF = KS_BYTES;
typedef short v4i16_t __attribute__((ext_vector_type(4)));
__device__ __forceinline__ u32x2 vtr(const LAS unsigned char* p) { return __builtin_bit_cast(u32x2, __builtin_amdgcn_ds_read_tr16_b64_v4i16((LAS v4i16_t*)p)); }
__device__ __forceinline__ void band_load_kv(u32x4 (&kr)[4], u32x4 (&vr)[4], const bf16_t* K, const bf16_t* V, int ldkv, int kvcol, int rowbase, int dil, int res, int s0, bool has_prev, int tid) {
#pragma unroll
    for (int it = 0; it < 4; ++it) {
        const int idx = tid + 512 * it, key = idx >> 3, ch = idx & 7;
        const int s = s0 - 128 + key; const bool ok = has_prev || key >= 128;
        const size_t roff = (size_t)(rowbase + dil * (ok ? s : s0) + res) * ldkv + kvcol + ch * 8;
        kr[it] = *(const u32x4*)(K + roff); vr[it] = *(const u32x4*)(V + roff);
        if (!ok) { kr[it] = (u32x4){0u, 0u, 0u, 0u}; vr[it] = kr[it]; }
    }
}
__device__ __forceinline__ void band_store_kv(LAS unsigned char* lds, const u32x4 (&kr)[4], const u32x4 (&vr)[4], int tid) {
#pragma unroll
    for (int it = 0; it < 4; ++it) {
        const int idx = tid + 512 * it, key = idx >> 3, ch = idx & 7;
        *(LAS u32x4*)(lds + key * KS_STRIDE + ch * 16) = kr[it];
        *(LAS u32x4*)(lds + VT_OFF + key * KS_STRIDE + ch * 16) = vr[it];
    }
}
__device__ __forceinline__ void band_head(LAS unsigned char* lds, const bf16x8 q0, const bf16x8 q1  , bool has_prev, int w, int lane, f32x4 (&o)[4], float& mrow, float& lrow) {
    const int fr = lane & 15, fq = lane >> 4;
    f32x4 st[10];
#pragma unroll
    for (int T = 0; T < 9; ++T) {
        const LAS unsigned char* kp = lds + (16 * (w + T) + fr) * KS_STRIDE + fq * 16;
        const bf16x8 k0 = *(const LAS bf16x8*)kp, k1 = *(const LAS bf16x8*)(kp + 64);
        f32x4 a = (f32x4){0.f, 0.f, 0.f, 0.f};
        a = __builtin_amdgcn_mfma_f32_16x16x32_bf16(k0, q0, a, 0, 0, 0);
        a = __builtin_amdgcn_mfma_f32_16x16x32_bf16(k1, q1, a, 0, 0, 0);
        st[T] = a;
        if (T & 1) __builtin_amdgcn_sched_barrier(0);
    }
    float mx = -INFINITY;
#pragma unroll
    for (int T = 0; T < 9; ++T)
#pragma unroll
        for (int r = 0; r < 4; ++r) {
            const int dlt = 16 * T + 4 * fq + r - fr;
            const int j = 16 * (w + T) + 4 * fq + r;
            const bool ok = dlt >= 0 && dlt <= 128 && (has_prev || j >= 128);
            const float s = ok ? st[T][r] : -INFINITY; st[T][r] = s; mx = fmaxf(mx, s);
        }
    mx = fmaxf(mx, __shfl_xor(mx, 16)); mx = fmaxf(mx, __shfl_xor(mx, 32));
    float ls = 0.f;
#pragma unroll
    for (int T = 0; T < 9; ++T)
#pragma unroll
        for (int r = 0; r < 4; ++r) { const float p = __builtin_amdgcn_exp2f(st[T][r] - mx); st[T][r] = p; ls += p; }
    st[9] = (f32x4){0.f, 0.f, 0.f, 0.f};
    ls += __shfl_xor(ls, 16); ls += __shfl_xor(ls, 32);
#pragma unroll
    for (int dt = 0; dt < 4; ++dt) o[dt] = (f32x4){0.f, 0.f, 0.f, 0.f};
#pragma unroll
    for (int pp = 0; pp < 5; ++pp) {
        u32x4 pw; pw.x = pk2(st[2 * pp][0], st[2 * pp][1]); pw.y = pk2(st[2 * pp][2], st[2 * pp][3]); pw.z = pk2(st[2 * pp + 1][0], st[2 * pp + 1][1]); pw.w = pk2(st[2 * pp + 1][2], st[2 * pp + 1][3]);
        const bf16x8 pf = __builtin_bit_cast(bf16x8, pw);
        const int kt0 = w + 2 * pp, kt1 = (kt0 + 1 > 15) ? 15 : kt0 + 1;
#pragma unroll
        for (int dt = 0; dt < 4; ++dt) {
            const LAS unsigned char* vp = lds + VT_OFF + (4 * fq + ((lane >> 2) & 3)) * KS_STRIDE + (lane & 3) * 8 + dt * 32;
            const u32x2 va = vtr(vp + kt0 * 16 * KS_STRIDE), vb = vtr(vp + kt1 * 16 * KS_STRIDE);
            u32x4 vw; vw.x = va.x; vw.y = va.y; vw.z = vb.x; vw.w = vb.y;
            o[dt] = __builtin_amdgcn_mfma_f32_16x16x32_bf16(__builtin_bit_cast(bf16x8, vw), pf, o[dt], 0, 0, 0);
        }
        __builtin_amdgcn_sched_barrier(0);
    }
    mrow = mx; lrow = ls;
}

template <int NBR>
__device__ __forceinline__ void dec_attn(const bf16_t* q, const float* Kc, const float* Vc, const float* Kn, const float* Vn, int rs, int nbuf, int t, int lane, f32x4& oout, float& lse) {
    const int sub = lane >> 4, c = lane & 15;
    const u32x2 qw = *(const u32x2*)(q + 4 * c);
    const f32x4 q4 = (f32x4){bf2f((unsigned short)(qw.x & 0xffffu)), bf2f((unsigned short)(qw.x >> 16)), bf2f((unsigned short)(qw.y & 0xffffu)), bf2f((unsigned short)(qw.y >> 16))};
    float m = -INFINITY, l = 0.f; f32x4 acc = (f32x4){0.f, 0.f, 0.f, 0.f};
#pragma unroll 1
    for (int bb = 0; bb < NBR * 3; ++bb) {
        const int br = bb / 3, jb = bb - 3 * br; const int dil = br == 0 ? 1 : (br == 1 ? 4 : 16);
        f32x4 k4[11], v4[11]; float s[11]; float bm = -INFINITY;
#pragma unroll
        for (int u = 0; u < 11; ++u) {
            const int jt = 11 * jb + u; const int j = 4 * jt + sub; const bool ok = jt < 32 || sub == 0;
            const int idx = nbuf + t - dil * (ok ? j : 0);
            const float* kp = idx < nbuf ? Kc + (size_t)idx * rs : Kn + (size_t)(idx - nbuf) * rs;
            const float* vp = idx < nbuf ? Vc + (size_t)idx * rs : Vn + (size_t)(idx - nbuf) * rs;
            k4[u] = *(const f32x4*)(kp + 4 * c); v4[u] = *(const f32x4*)(vp + 4 * c);
        }
#pragma unroll
        for (int u = 0; u < 11; ++u) {
            const int jt = 11 * jb + u; const bool ok = jt < 32 || sub == 0;
            float x = (q4[0] * k4[u][0] + q4[1] * k4[u][1]) + (q4[2] * k4[u][2] + q4[3] * k4[u][3]);
            x = row16_sum(x); if (!ok) x = -INFINITY;
            s[u] = x; bm = fmaxf(bm, x);
        }
        const float mn = fmaxf(m, bm), corr = __builtin_amdgcn_exp2f(m - mn);
        l *= corr; acc = acc * corr; m = mn;
#pragma unroll
        for (int u = 0; u < 11; ++u) { const float p = __builtin_amdgcn_exp2f(s[u] - mn); l += p; acc = acc + v4[u] * p; }
    }
#pragma unroll
    for (int o = 16; o <= 32; o <<= 1) {
        const float mo = __shfl_xor(m, o), lo = __shfl_xor(l, o);
        f32x4 ao; ao[0] = __shfl_xor(acc[0], o); ao[1] = __shfl_xor(acc[1], o); ao[2] = __shfl_xor(acc[2], o); ao[3] = __shfl_xor(acc[3], o);
        const float mn = fmaxf(m, mo), c0 = __builtin_amdgcn_exp2f(m - mn), c1 = __builtin_amdgcn_exp2f(mo - mn);
        l = l * c0 + lo * c1; acc = acc * c0 + ao * c1; m = mn;
    }
    oout = acc * (1.0f / l); lse = (m + __builtin_amdgcn_logf(l)) * LN2F;
}

constexpr int XL_STRIDE = 528;
constexpr int PRE_WOFF = 68096, PRE_WS = 208;
__device__ __forceinline__ void rwkv_stage_weights(LAS unsigned char* lds, const bf16_t* wlt, int h, int tid) {
    for (int idx = tid; idx < 3 * 64 * 12; idx += 512) {
        const int mat = idx / 768, rem = idx - 768 * mat, row = rem / 12, chn = rem - 12 * row;
        *(LAS u32x4*)(lds + PRE_WOFF + (mat * 64 + row) * PRE_WS + chn * 16) = *(const u32x4*)(wlt + (size_t)mat * 512 * 96 + (size_t)(h * 64 + row) * 96 + chn * 8);
    }
}
struct RwkvW { const float *mu, *w0, *a0, *kk, *ka, *rk; const bf16_t* wlt; };
__device__ __forceinline__ void rwkv_prepass_tile(LAS unsigned char* lds, const float* PB, int prow0, const float* prev0, int ntok, int h, const RwkvW& W, float* OPS, float* GG, float* BON, int th0, int tid_in, int w) {
    int tid = tid_in; asm volatile("" : "+v"(tid));
    const int lane = tid & 63;
    {
        const int k = (tid & 63) * 4;
        const f32x4 mu4 = *(const f32x4*)(W.mu + 1536 + k);
        const f32x4 z4 = (f32x4){0.f, 0.f, 0.f, 0.f};
#define PRE_LOAD(i0_, cd, pd) do { _Pragma("unroll") for (int u = 0; u < 8; ++u) { \
            const int i = (i0_) + 8 * u; const int ii = i < ntok ? i : 0; \
            cd[u] = *(const f32x4*)(PB + (size_t)(prow0 + ii) * BCOLS + 1536 + k); \
            const float* pp = ii > 0 ? PB + (size_t)(prow0 + ii - 1) * BCOLS : prev0; \
            pd[u] = pp ? *(const f32x4*)(pp + 1536 + k) : z4; } } while (0)
        f32x4 cur[8], prv[8], curn[8], prvn[8];
        PRE_LOAD(w, cur, prv);
#pragma unroll 1
        for (int i0 = w; i0 < ntok; i0 += 64) {
            if (i0 + 64 < ntok) PRE_LOAD(i0 + 64, curn, prvn);
#pragma unroll
            for (int u = 0; u < 8; ++u) {
                const int i = i0 + 8 * u;
                f32x4 x = cur[u] + (prv[u] - cur[u]) * mu4;
                if (k < 96) { x[0] = tanhf_(x[0]); x[1] = tanhf_(x[1]); x[2] = tanhf_(x[2]); x[3] = tanhf_(x[3]); }
                else if (k >= 192) { x[0] = sigmoidf_(x[0]); x[1] = sigmoidf_(x[1]); x[2] = sigmoidf_(x[2]); x[3] = sigmoidf_(x[3]); }
                u32x2 o; o.x = pk2(x[0], x[1]); o.y = pk2(x[2], x[3]);
                if (i < ntok) *(LAS u32x2*)(lds + i * XL_STRIDE + k * 2) = o;
            }
#pragma unroll
            for (int u = 0; u < 8; ++u) { cur[u] = curn[u]; prv[u] = prvn[u]; }
        }
#undef PRE_LOAD
    }
    __syncthreads();
#pragma unroll 1
    for (int mt = w; 16 * mt < ntok; mt += 8) {
        int lane2 = lane; asm volatile("" : "+v"(lane2));
        const int fr = lane2 & 15, fq = lane2 >> 4;
        const int i = 16 * mt + fr; const bool tok_ok = i < ntok; const int ic = tok_ok ? i : 0;
        f32x4 aw[4], aa[4], ag[4];
#pragma unroll
        for (int nt = 0; nt < 4; ++nt) { aw[nt] = (f32x4){0.f, 0.f, 0.f, 0.f}; aa[nt] = aw[nt]; ag[nt] = aw[nt]; }
        const LAS unsigned char* xrow = lds + (16 * mt + fr) * XL_STRIDE + fq * 16;
#pragma unroll
        for (int ks = 0; ks < 3; ++ks) {
            const bf16x8 xw = *(const LAS bf16x8*)(xrow + ks * 64), xa = *(const LAS bf16x8*)(xrow + 192 + ks * 64);
            bf16x8 xg = xw; if (ks < 2) xg = *(const LAS bf16x8*)(xrow + 384 + ks * 64);
#pragma unroll
            for (int nt = 0; nt < 4; ++nt) {
                const LAS unsigned char* wp = lds + PRE_WOFF + (16 * nt + fr) * PRE_WS + ks * 64 + fq * 16;
                aw[nt] = __builtin_amdgcn_mfma_f32_16x16x32_bf16(*(const LAS bf16x8*)wp, xw, aw[nt], 0, 0, 0);
                aa[nt] = __builtin_amdgcn_mfma_f32_16x16x32_bf16(*(const LAS bf16x8*)(wp + 64 * PRE_WS), xa, aa[nt], 0, 0, 0);
                if (ks < 2) ag[nt] = __builtin_amdgcn_mfma_f32_16x16x32_bf16(*(const LAS bf16x8*)(wp + 128 * PRE_WS), xg, ag[nt], 0, 0, 0);
            }
            __builtin_amdgcn_sched_barrier(0);
        }
        const float* cur = PB + (size_t)(prow0 + ic) * BCOLS;
        const float* prv = ic > 0 ? PB + (size_t)(prow0 + ic - 1) * BCOLS : prev0;
        const f32x4 z4 = (f32x4){0.f, 0.f, 0.f, 0.f};
        f32x4 cr[4], ck[4], cv[4], pr[4], pk[4], pv[4];
#pragma unroll
        for (int nt = 0; nt < 4; ++nt) {
            const int ch = h * 64 + 16 * nt + 4 * fq;
            cr[nt] = *(const f32x4*)(cur + ch); ck[nt] = *(const f32x4*)(cur + 512 + ch); cv[nt] = *(const f32x4*)(cur + 1024 + ch);
            pr[nt] = prv ? *(const f32x4*)(prv + ch) : z4; pk[nt] = prv ? *(const f32x4*)(prv + 512 + ch) : z4; pv[nt] = prv ? *(const f32x4*)(prv + 1024 + ch) : z4;
        }
        float nrm = 0.f;
#pragma unroll
        for (int nt = 0; nt < 4; ++nt) {
            const int ch = h * 64 + 16 * nt + 4 * fq;
            const f32x4 mk = *(const f32x4*)(W.mu + 512 + ch), kk = *(const f32x4*)(W.kk + ch);
            ck[nt] = ck[nt] + (pk[nt] - ck[nt]) * mk;
            const f32x4 kp = ck[nt] * kk;
            nrm += (kp[0] * kp[0] + kp[1] * kp[1]) + (kp[2] * kp[2] + kp[3] * kp[3]);
        }
        nrm += __shfl_xor(nrm, 16); nrm += __shfl_xor(nrm, 32);
        const float inv = 1.0f / fmaxf(sqrtf(nrm), 1e-12f);
        float bon = 0.f;
        float* op = OPS + (size_t)(th0 + ic) * 384; float* gp = GG + (size_t)(th0 + ic) * 64;
#pragma unroll
        for (int nt = 0; nt < 4; ++nt) {
            const int ch = h * 64 + 16 * nt + 4 * fq, cc = 16 * nt + 4 * fq;
            const f32x4 mr = *(const f32x4*)(W.mu + ch), mv = *(const f32x4*)(W.mu + 1024 + ch);
            const f32x4 rs = cr[nt] + (pr[nt] - cr[nt]) * mr, ksh = ck[nt], vs = cv[nt] + (pv[nt] - cv[nt]) * mv;
            const f32x4 w0 = *(const f32x4*)(W.w0 + ch), a0 = *(const f32x4*)(W.a0 + ch), kk = *(const f32x4*)(W.kk + ch), ka = *(const f32x4*)(W.ka + ch), rk = *(const f32x4*)(W.rk + ch);
            f32x4 dv, av, kmod;
#pragma unroll
            for (int r = 0; r < 4; ++r) {
                const float wp = w0[r] + aw[nt][r];
                const float sp = (-wp > 20.f) ? -wp : LN2F * __builtin_amdgcn_logf(1.0f + __builtin_amdgcn_exp2f(-1.4426950408889634f * wp));
                dv[r] = __builtin_amdgcn_exp2f(-1.4426950408889634f * __builtin_amdgcn_exp2f(1.4426950408889634f * (-sp - 0.5f)));
                const float a = sigmoidf_(a0[r] + aa[nt][r]); av[r] = a;
                kmod[r] = ksh[r] * (1.0f + (a - 1.0f) * ka[r]);
                bon += rs[r] * kmod[r] * rk[r];
            }
            const f32x4 kkn = ksh * kk * inv;
            if (tok_ok) {
                *(f32x4*)(op + 0 * 64 + cc) = kkn; *(f32x4*)(op + 1 * 64 + cc) = dv; *(f32x4*)(op + 2 * 64 + cc) = kkn * av;
                *(f32x4*)(op + 3 * 64 + cc) = kmod; *(f32x4*)(op + 4 * 64 + cc) = rs; *(f32x4*)(op + 5 * 64 + cc) = vs;
                *(f32x4*)(gp + cc) = ag[nt];
            }
        }
        bon += __shfl_xor(bon, 16); bon += __shfl_xor(bon, 32);
        if (tok_ok && fq == 0) BON[th0 + i] = bon;
    }
    __syncthreads();
}

__device__ __forceinline__ float row8_sum(float v) {
    v = DPP_ADD(v, 0xB1);
    v = DPP_ADD(v, 0x4E);
    v = DPP_ADD(v, 0x141);
    return v;
}
__device__ __forceinline__ float dot8(const f32x2 (&s)[4], const f32x2 (&o)[4]) { f32x2 a = s[0] * o[0]; a = s[1] * o[1] + a; a = s[2] * o[2] + a; a = s[3] * o[3] + a; return a.x + a.y; }
template <bool WITH_P>
__device__ __forceinline__ void rwkv_scan_t(LAS unsigned char* lds, const float* OPS, int th0, int nsteps, const float* init  , float* yz, int ystride, float* zend, float* pend, int tid, int w) {
    int lane = tid & 63; asm volatile("" : "+v"(lane));
    const int r = lane >> 3, jl = lane & 7, row = 8 * w + r;
    f32x2 Z[4], P[4];
#pragma unroll
    for (int q = 0; q < 4; ++q) {
        const int j = 8 * jl + 2 * q;
        P[q] = (f32x2){row == j ? 1.f : 0.f, row == j + 1 ? 1.f : 0.f};
        Z[q] = init ? *(const f32x2*)(init + row * 64 + j) : (f32x2){0.f, 0.f};
    }
    const f32x4* src = (const f32x4*)(OPS + (size_t)th0 * 384);
    const int nchunks = (nsteps + 31) >> 5;
    f32x4 pre[6];
#pragma unroll
    for (int k = 0; k < 6; ++k) { const int q = tid + 512 * k; pre[k] = (q < nsteps * 96) ? src[q] : (f32x4){0.f, 0.f, 0.f, 0.f}; }
#pragma unroll
    for (int k = 0; k < 6; ++k) *(LAS f32x4*)(lds + (size_t)(tid + 512 * k) * 16) = pre[k];
    for (int c = 0; c < nchunks; ++c) {
        __syncthreads();
        const bool more = c + 1 < nchunks;
        if (more) {
            int t2 = tid; asm volatile("" : "+v"(t2));
            const f32x4* s2 = (const f32x4*)(OPS + (size_t)th0 * 384) + (c + 1) * 3072 + t2;
#pragma unroll
            for (int k = 0; k < 6; ++k) { const int q = (c + 1) * 3072 + t2 + 512 * k; pre[k] = (q < nsteps * 96) ? s2[512 * k] : (f32x4){0.f, 0.f, 0.f, 0.f}; }
        }
        const LAS unsigned char* buf = lds + (c & 1) * 49152;
        const int nst = (nsteps - 32 * c) < 32 ? (nsteps - 32 * c) : 32;
#pragma unroll 1
        for (int t8 = 0; t8 < nst; t8 += 8) {
            float qz[8], qp[8];
#pragma unroll
            for (int u = 0; u < 8; ++u) {
                const LAS float* op = (const LAS float*)(buf + (t8 + u) * 1536) + 8 * jl;
                f32x2 kk[4], d[4], b[4], k[4], rr[4];
                { const f32x4 a0 = *(const LAS f32x4*)(op), a1 = *(const LAS f32x4*)(op + 4); kk[0] = (f32x2){a0[0], a0[1]}; kk[1] = (f32x2){a0[2], a0[3]}; kk[2] = (f32x2){a1[0], a1[1]}; kk[3] = (f32x2){a1[2], a1[3]}; }
                { const f32x4 a0 = *(const LAS f32x4*)(op + 64), a1 = *(const LAS f32x4*)(op + 68); d[0] = (f32x2){a0[0], a0[1]}; d[1] = (f32x2){a0[2], a0[3]}; d[2] = (f32x2){a1[0], a1[1]}; d[3] = (f32x2){a1[2], a1[3]}; }
                { const f32x4 a0 = *(const LAS f32x4*)(op + 128), a1 = *(const LAS f32x4*)(op + 132); b[0] = (f32x2){a0[0], a0[1]}; b[1] = (f32x2){a0[2], a0[3]}; b[2] = (f32x2){a1[0], a1[1]}; b[3] = (f32x2){a1[2], a1[3]}; }
                { const f32x4 a0 = *(const LAS f32x4*)(op + 192), a1 = *(const LAS f32x4*)(op + 196); k[0] = (f32x2){a0[0], a0[1]}; k[1] = (f32x2){a0[2], a0[3]}; k[2] = (f32x2){a1[0], a1[1]}; k[3] = (f32x2){a1[2], a1[3]}; }
                { const f32x4 a0 = *(const LAS f32x4*)(op + 256), a1 = *(const LAS f32x4*)(op + 260); rr[0] = (f32x2){a0[0], a0[1]}; rr[1] = (f32x2){a0[2], a0[3]}; rr[2] = (f32x2){a1[0], a1[1]}; rr[3] = (f32x2){a1[2], a1[3]}; }
                const float vv = *((const LAS float*)(buf + (t8 + u) * 1536) + 320 + row);
                const float saz = -row8_sum(dot8(Z, kk));
                float sap = 0.f; if (WITH_P) sap = -row8_sum(dot8(P, kk));
#pragma unroll
                for (int q = 0; q < 4; ++q) { Z[q] = Z[q] * d[q] + (b[q] * saz + k[q] * vv); if (WITH_P) P[q] = P[q] * d[q] + b[q] * sap; }
                qz[u] = dot8(Z, rr); if (WITH_P) qp[u] = dot8(P, rr);
            }
            float yzv = 0.f, ypv = 0.f;
#pragma unroll
            for (int u = 0; u < 8; ++u) { const float s = row8_sum(qz[u]); yzv = (jl == u) ? s : yzv; if (WITH_P) { const float s2 = row8_sum(qp[u]); ypv = (jl == u) ? s2 : ypv; } }
            int l3 = lane; asm volatile("" : "+v"(l3));
            float* yp = yz + (size_t)(32 * c + t8 + (l3 & 7)) * ystride + 8 * w + (l3 >> 3);
            if (t8 + (l3 & 7) < nst) { *yp = yzv; if (WITH_P) yp[64] = ypv; }
        }
        if (more) {
            LAS unsigned char* nb = lds + ((c + 1) & 1) * 49152;
#pragma unroll
            for (int k = 0; k < 6; ++k) *(LAS f32x4*)(nb + (size_t)(tid + 512 * k) * 16) = pre[k];
        }
    }
    {
        int l2 = lane; asm volatile("" : "+v"(l2));
        const int o = (8 * w + (l2 >> 3)) * 64 + 8 * (l2 & 7);
#pragma unroll
        for (int q = 0; q < 4; ++q) { *(f32x2*)(zend + o + 2 * q) = Z[q]; if (WITH_P) *(f32x2*)(pend + o + 2 * q) = P[q]; }
    }
    __syncthreads();
}
__device__ __forceinline__ void rwkv_scan(LAS unsigned char* lds, const float* OPS, int th0, int nsteps, const float* init, bool with_p, float* yz, int ystride, float* zend, float* pend, int tid, int w) {
    if (with_p) rwkv_scan_t<true>(lds, OPS, th0, nsteps, init, yz, ystride, zend, pend, tid, w);
    else rwkv_scan_t<false>(lds, OPS, th0, nsteps, init, yz, ystride, zend, pend, tid, w);
}

__device__ __forceinline__ void rwkv_out_token(float y, float lw, float lb, float bon, float v, float g, bf16_t* dst) {
    const float mean = wave_sum(y) * (1.0f / 64.0f); const float dlt = y - mean;
    const float var = wave_sum(dlt * dlt) * (1.0f / 64.0f);
    const float yn = dlt * rsqrtf(var + GN_EPS) * lw + lb;
    *dst = (bf16_t)f2bf((yn + bon * v) * g);
}

#ifndef REP_M1A
#define REP_M1A 1
#endif
#ifndef REP_M1B
#define REP_M1B 1
#endif
#ifndef REP_M1C
#define REP_M1C 1
#endif
#ifndef REP_M1D
#define REP_M1D 1
#endif
#ifndef REP_PIN
#define REP_PIN 1
#endif
#ifndef REP_M2
#define REP_M2 1
#endif
#ifndef REP_PGU
#define REP_PGU 1
#endif
#ifndef REP_POUT
#define REP_POUT 1
#endif
#ifndef REP_PDN
#define REP_PDN 1
#endif
struct Args { const float* in[28]; float* out; unsigned char* ws; };
enum { I_XP = 0, I_XS, I_CAK, I_CAV, I_CCK, I_CCV, I_WKV, I_SHIFT, I_GMIX, I_WIN, I_WOUT, I_MU, I_W0, I_W2, I_A0, I_A2, I_G2, I_KK, I_KA, I_RK, I_LNW, I_LNB, I_SINK, I_GFFN, I_WG, I_WU, I_WD, I_GFIN };

#define G_SSQ ((float*)(ws + WS_CTL + SSQ_OFF))
#define G_ROPE ((float*)(ws + WS_ROPE))
#define G_WLT ((bf16_t*)(ws + WS_WLT))
#define G_X ((float*)(ws + WS_X))
#define G_XN ((bf16_t*)(ws + WS_XN))
#define G_QA ((bf16_t*)(ws + WS_QA))
#define G_KA ((bf16_t*)(ws + WS_KA))
#define G_VA ((bf16_t*)(ws + WS_VA))
#define G_QC ((bf16_t*)(ws + WS_QC))
#define G_KC ((bf16_t*)(ws + WS_KC))
#define G_VC ((bf16_t*)(ws + WS_VC))
#define G_PB ((float*)(ws + WS_PB))
#define G_MIX ((bf16_t*)(ws + WS_MIX))
#define G_ACT ((bf16_t*)(ws + WS_ACT))
#define G_OA ((bf16_t*)(ws + WS_OA))
#define G_LSE ((float*)(ws + WS_LSE))
#define G_OPS ((float*)(ws + WS_OPS))
#define G_GG ((float*)(ws + WS_GG))
#define G_BON ((float*)(ws + WS_BON))
#define G_YZ ((float*)(ws + WS_YZ))
#define G_YS ((float*)(ws + WS_YS))
#define G_ENDS ((float*)(ws + WS_ENDS))
#define G_PART ((float*)(ws + WS_PART))
#define G_WIN ((bf16_t*)(ws + WS_WIN))
#define G_WOUT ((bf16_t*)(ws + WS_WOUT))
#define G_WGU ((bf16_t*)(ws + WS_WGU))
#define G_WDN ((bf16_t*)(ws + WS_WDN))
constexpr int PTAB_OFF = RING_BYTES + 1024;
template <class T> __device__ __forceinline__ T* ldptr(LAS unsigned char* lds, int i) {
    unsigned lo, hi; const unsigned addr = (unsigned)(uintptr_t)(lds + PTAB_OFF + 8 * i);
    asm volatile("v_mov_b32 %0, %2\n\tv_mov_b32 %1, %2\n\tds_read_b32 %0, %0\n\tds_read_b32 %1, %1 offset:4\n\ts_waitcnt lgkmcnt(0)" : "=&v"(lo), "=&v"(hi) : "s"(addr) : "memory");
    lo = __builtin_amdgcn_readfirstlane(lo); hi = __builtin_amdgcn_readfirstlane(hi);
    typedef __attribute__((address_space(1))) T GT;
    return (T*)(GT*)(((unsigned long long)hi << 32) | lo);
}
#define IN(i) ldptr<const float>(lds, (i))
#define GRID_BAR() do { XcdBarrier b_; b_.bar = (unsigned*)(ldptr<unsigned char>(lds, 29) + WS_CTL) + CW_BAR; b_.x = xb_xcc_id(); b_.st = (volatile LAS unsigned*)(lds + MISC_OFF) + 8; \
    int ln_; asm volatile("v_mbcnt_lo_u32_b32 %0, -1, 0\n\tv_mbcnt_hi_u32_b32 %0, -1, %0" : "=v"(ln_)); xcd_barrier(b_, wave0 == 0 && ln_ == 0); } while (0)
#define PHASE_BEGIN \
    int wave = wave0; asm volatile("" : "+s"(wave)); int vcu = vcu0; asm volatile("" : "+s"(vcu)); \
    int lane; asm volatile("v_mbcnt_lo_u32_b32 %0, -1, 0\n\tv_mbcnt_hi_u32_b32 %0, -1, %0" : "=v"(lane)); const int tid = wave * 64 + lane; (void)tid; \
    unsigned char* ws = ldptr<unsigned char>(lds, 29); float* out = ldptr<float>(lds, 28); (void)out; \
    const int gw = vcu * 8 + wave, gt = vcu * 512 + tid; (void)gw; (void)gt;

__global__ void __launch_bounds__(512, 2) fwd(Args args) {
    extern __shared__ __attribute__((aligned(16))) unsigned char lds_raw[];
    LAS unsigned char* lds = (LAS unsigned char*)lds_raw;
    const int tid0 = threadIdx.x, wave0 = __builtin_amdgcn_readfirstlane(tid0 >> 6);
    const int G = gridDim.x, bx = blockIdx.x;
    const int vcu0 = (G % 8 == 0) ? (bx % 8) * (G / 8) + bx / 8 : bx;
    const int NGW = G * 8, NGT = G * 512;
    volatile LAS unsigned* MISC = (volatile LAS unsigned*)(lds + MISC_OFF);
    for (int u = tid0; u < (LDS_BYTES - RING_BYTES) / 4; u += 512) ((LAS unsigned*)(lds + RING_BYTES))[u] = 0u;
    __syncthreads();
    if (tid0 == 0) {
#pragma unroll
        for (int i = 0; i < 28; ++i) *(LAS unsigned long long*)(lds + PTAB_OFF + 8 * i) = (unsigned long long)args.in[i];
        *(LAS unsigned long long*)(lds + PTAB_OFF + 8 * 28) = (unsigned long long)args.out;
        *(LAS unsigned long long*)(lds + PTAB_OFF + 8 * 29) = (unsigned long long)args.ws;
    }
    __syncthreads();
    (void)xcd_barrier_post((unsigned*)(args.ws + WS_CTL) + CW_BAR, MISC + 8);

#ifndef SKIP_P0
    {
        PHASE_BEGIN
        LAS unsigned char* scr = lds + wave * 16384;
        for (int it = gw; it < IT_IN; it += NGW) CONV_ITEM_A(0, it);
        for (int e = gt; e < DEPTH * 3 * 512 * 96; e += NGT) {
            const int k = e % 96, ch = (e / 96) % 512, mat = (e / (96 * 512)) % 3, l = e / (96 * 512 * 3);
            float v = 0.f;
            if (mat == 0) v = IN(I_W2)[((size_t)l * 96 + k) * 512 + ch];
            else if (mat == 1) v = IN(I_A2)[((size_t)l * 96 + k) * 512 + ch];
            else if (k < 64) v = IN(I_G2)[((size_t)l * 64 + k) * 512 + ch];
            G_WLT[e] = (bf16_t)f2bf(v);
        }
        for (int e = gt; e < 2056 * 8; e += NGT) {
            const int pi = e >> 3, i = e & 7; const int pos = pi < SEQ ? pi : PASTLEN + (pi - SEQ);
            const float inv = expf(-logf(500000.0f) * (float)i * 2.0f / 16.0f);
            const float ang = (float)pos * inv;
            G_ROPE[pi * 16 + i] = (float)cos((double)ang); G_ROPE[pi * 16 + 8 + i] = (float)sin((double)ang);
        }
        for (int m = gw; m < MTOT; m += NGW) {
            const float* xr = m < MP ? IN(I_XP) + (size_t)m * DM : IN(I_XS) + (size_t)(m - MP) * DM;
            float s = 0.f;
#pragma unroll
            for (int j = 0; j < 8; ++j) { const f32x4 v = *(const f32x4*)(xr + 4 * lane + 256 * j);
                u32x2 o; o.x = pk2(v[0], v[1]); o.y = pk2(v[2], v[3]); *(u32x2*)(G_XN + (size_t)m * DM + 4 * lane + 256 * j) = o;
                s += (v[0] * v[0] + v[1] * v[1]) + (v[2] * v[2] + v[3] * v[3]); }
            s = wave_sum(s); if (lane == 0) G_SSQ[m] = s;
        }
    }
#endif
    GRID_BAR();

    for (int l = 0; l < DEPTH; ++l) {
#ifndef SKIP_PIN
        _Pragma("unroll 1") for (int rep_ = 0; rep_ < REP_PIN; ++rep_) {
            PHASE_BEGIN
            pg8::Gemm g{G_XN, G_WIN + (size_t)l * INC * DM, MTOT, INC, DM, DM}; pg8::StaticOrder S; S.init(MTOT, INC, G, bx);
            pg8::EpiIn E; E.ssq = G_SSQ + (size_t)(2 * l) * MTOT; E.rope = G_ROPE; E.QA = G_QA; E.KA = G_KA; E.VA = G_VA; E.QC = G_QC; E.KC = G_KC; E.VC = G_VC; E.PB = G_PB;
            E.o_ak_p = out + O_AKP + (size_t)l * MP * 512; E.o_av_p = out + O_AVP + (size_t)l * MP * 512; E.o_ck_p = out + O_CKP + (size_t)l * NBATCH * 128 * 128; E.o_cv_p = out + O_CVP + (size_t)l * NBATCH * 128 * 128;
            E.o_sh_p = out + O_SHP + (size_t)l * NBATCH * BCOLS; E.o_ak_s = out + O_AKS + (size_t)l * MS * 512; E.o_av_s = out + O_AVS + (size_t)l * MS * 512;
            E.o_ck_s = out + O_CKS + (size_t)l * MS * 128; E.o_cv_s = out + O_CVS + (size_t)l * MS * 128; E.o_sh_s = out + O_SHS + (size_t)l * DECB * BCOLS;
            pg8::gemm_phase<pg8::EpiIn, pg8::StaticOrder, true, true>(lds, g, S, E, wave);
            constexpr int NIDLE = 256 - ((MTOT / 256) * (INC / 256) - 512);
            if (rep_ == 0 && bx >= 256 - NIDLE) {
                LAS unsigned char* scr = lds + wave * 16384;
                const int nit = (IT_A - IT_IN) + (l + 1 < DEPTH ? IT_IN : 0);
                for (int it = (bx - (256 - NIDLE)) * 8 + wave; it < nit; it += NIDLE * 8) { if (it < IT_A - IT_IN) CONV_ITEM_A(l, IT_IN + it); else CONV_ITEM_A(l + 1, it - (IT_A - IT_IN)); }
                for (int it = (bx - (256 - NIDLE)) * 8 + wave; it < IT_B / 2; it += NIDLE * 8) CONV_ITEM_B(l, it);
            }
        }
#endif
        GRID_BAR();

#ifndef SKIP_M1
        {
            PHASE_BEGIN
#ifndef SKIP_M1A
            _Pragma("unroll 1") for (int rep_ = 0; rep_ < REP_M1A; ++rep_) { PHASE_BEGIN
                RwkvW W; W.mu = IN(I_MU) + l * BCOLS; W.w0 = IN(I_W0) + l * 512; W.a0 = IN(I_A0) + l * 512; W.kk = IN(I_KK) + l * 512; W.ka = IN(I_KA) + l * 512; W.rk = IN(I_RK) + l * 512;
                W.wlt = G_WLT + (size_t)l * 3 * 512 * 96;
            for (int task = vcu; task < 256; task += G) {
                const int seg = task & 7, h = (task >> 3) & 7, b = task >> 6;
                const int prow = b * SEQ + seg * 256, th0 = (b * 8 + h) * SEQ + seg * 256;
                rwkv_stage_weights(lds, W.wlt, h, tid);
#pragma unroll 1
                for (int tt = 0; tt < 2; ++tt) {
                    const int p0 = prow + 128 * tt; const float* prev0 = (seg == 0 && tt == 0) ? nullptr : G_PB + (size_t)(p0 - 1) * BCOLS;
                    rwkv_prepass_tile(lds, G_PB, p0, prev0, 128, h, W, G_OPS, G_GG, G_BON, th0 + 128 * tt, tid, wave);
                }
                rwkv_scan(lds, G_OPS, th0, 256, nullptr, seg > 0, G_YZ + (size_t)th0 * 128, 128, G_ENDS + (size_t)task * 8192, G_ENDS + (size_t)task * 8192 + 4096, tid, wave);
            }
            }
#endif
#ifndef SKIP_M1B
            _Pragma("unroll 1") for (int rep_ = 0; rep_ < REP_M1B; ++rep_) { PHASE_BEGIN
                RwkvW W; W.mu = IN(I_MU) + l * BCOLS; W.w0 = IN(I_W0) + l * 512; W.a0 = IN(I_A0) + l * 512; W.kk = IN(I_KK) + l * 512; W.ka = IN(I_KA) + l * 512; W.rk = IN(I_RK) + l * 512;
                W.wlt = G_WLT + (size_t)l * 3 * 512 * 96;
            for (int task = vcu; task < 256; task += G) {
                const int h = task & 7, b = task >> 3; const int th0 = MP * 8 + task * 8;
                rwkv_stage_weights(lds, W.wlt, h, tid);
                rwkv_prepass_tile(lds, G_PB, MP + b * 8, IN(I_SHIFT) + ((size_t)l * DECB + b) * BCOLS, 8, h, W, G_OPS, G_GG, G_BON, th0, tid, wave);
                float* wo = out + O_WKVS + ((size_t)(l * DECB + b) * 8 + h) * 4096;
                rwkv_scan(lds, G_OPS, th0, 8, IN(I_WKV) + ((size_t)(l * DECB + b) * 8 + h) * 4096, false, G_YS + (size_t)task * 8 * 64, 64, wo, wo, tid, wave);
                {
                    const int t = wave, th = th0 + t;
                    rwkv_out_token(G_YS[(size_t)task * 512 + t * 64 + lane], IN(I_LNW)[l * 512 + h * 64 + lane], IN(I_LNB)[l * 512 + h * 64 + lane], G_BON[th], G_OPS[(size_t)th * 384 + 320 + lane], G_GG[(size_t)th * 64 + lane],
                                   G_MIX + (size_t)(MP + b * 8 + t) * DM + 512 + h * 64 + lane);
                }
            }
            }
#endif
#ifndef SKIP_M1C
            _Pragma("unroll 1") for (int rep_ = 0; rep_ < REP_M1C; ++rep_) { PHASE_BEGIN
            const int w = wave, fr = lane & 15, fq = lane >> 4;
            const int na = vcu < 128 ? 2 : 10;
#define A_TILE(k_) const int a_ = vcu < 128 ? vcu + 128 * (k_) : 256 + (vcu - 128) + 128 * (k_); \
                const int br = a_ >> 9, rem = a_ & 511, b = rem >> 7, h = (rem >> 4) & 7, u = rem & 15; \
                const int dil = br == 0 ? 1 : (br == 1 ? 4 : 16); \
                const int res = br == 0 ? 0 : (br == 1 ? (u >> 2) : u), qt = br == 0 ? u : (br == 1 ? (u & 3) : 0);
            u32x4 kr[4], vr[4];
            if (vcu < 128) {
                const int b = vcu >> 5, kvh = (vcu >> 4) & 1, qt = vcu & 15;
                band_load_kv(kr, vr, G_KC, G_VC, 128, kvh * 64, b * SEQ, 1, 0, 128 * qt, qt > 0, tid);
                band_store_kv(lds, kr, vr, tid);
                __syncthreads();
                { A_TILE(0) band_load_kv(kr, vr, G_KA, G_VA, 512, h * 64, b * SEQ, dil, res, 128 * qt, qt > 0, tid); }
                const int row = b * SEQ + 128 * qt + 16 * w + fr;
                const bf16_t* qp = G_QC + (size_t)row * 1024 + kvh * 512 + 8 * fq;
                bf16x8 qa = *(const bf16x8*)qp, qb = *(const bf16x8*)(qp + 32);
#pragma unroll 1
                for (int gq = 0; gq < 8; ++gq) {
                    const int qh = kvh * 8 + gq; f32x4 o[4]; float mrow, lrow;
                    const bf16x8 q0 = qa, q1 = qb;
                    if (gq + 1 < 8) { qa = *(const bf16x8*)(qp + (gq + 1) * 64); qb = *(const bf16x8*)(qp + (gq + 1) * 64 + 32); }
                    band_head(lds, q0, q1, qt > 0, w, lane, o, mrow, lrow);
                    const float lse = (mrow + __builtin_amdgcn_logf(lrow)) * LN2F;
                    const float sc = sigmoidf_(lse - IN(I_SINK)[l * 16 + qh]) / lrow;
#pragma unroll
                    for (int dt = 0; dt < 4; ++dt) { u32x2 ow; ow.x = pk2(o[dt][0] * sc, o[dt][1] * sc); ow.y = pk2(o[dt][2] * sc, o[dt][3] * sc);
                        *(u32x2*)(G_MIX + (size_t)row * DM + 1024 + qh * 64 + 16 * dt + 4 * fq) = ow; }
                }
            } else {
                A_TILE(0) band_load_kv(kr, vr, G_KA, G_VA, 512, h * 64, b * SEQ, dil, res, 128 * qt, qt > 0, tid);
            }
#pragma unroll 1
            for (int k = 0; k < na; ++k) {
                bf16x8 q0, q1;
                { A_TILE(k) const bf16_t* qp = G_QA + (size_t)(b * SEQ + dil * (128 * qt + 16 * w + fr) + res) * 512 + h * 64 + 8 * fq; q0 = *(const bf16x8*)qp; q1 = *(const bf16x8*)(qp + 32); }
                __syncthreads();
                band_store_kv(lds, kr, vr, tid);
                __syncthreads();
                if (k + 1 < na) { A_TILE(k + 1) band_load_kv(kr, vr, G_KA, G_VA, 512, h * 64, b * SEQ, dil, res, 128 * qt, qt > 0, tid); }
                A_TILE(k)
                const int row = b * SEQ + dil * (128 * qt + 16 * w + fr) + res;
                f32x4 o[4]; float mrow, lrow;
                band_head(lds, q0, q1, qt > 0, w, lane, o, mrow, lrow);
                const float inv = 1.0f / lrow;
#pragma unroll
                for (int dt = 0; dt < 4; ++dt) { u32x2 ow; ow.x = pk2(o[dt][0] * inv, o[dt][1] * inv); ow.y = pk2(o[dt][2] * inv, o[dt][3] * inv); *(u32x2*)(G_OA + ((size_t)br * MP + row) * 512 + h * 64 + 16 * dt + 4 * fq) = ow; }
                if (fq == 0) G_LSE[((size_t)br * MP + row) * 8 + h] = (mrow + __builtin_amdgcn_logf(lrow)) * LN2F;
            }
            __syncthreads();
#undef A_TILE
            }
#endif
#ifndef SKIP_M1D
            _Pragma("unroll 1") for (int rep_ = 0; rep_ < REP_M1D; ++rep_) { PHASE_BEGIN
            for (int wt = gw; wt < DECB * DECS * 8; wt += NGW) {
                const int h = wt & 7, t = (wt >> 3) & 7, b = wt >> 6; const int row = MP + b * 8 + t;
                const size_t cb = ((size_t)(l * DECB + b) * 2048) * 512 + h * 64, nb = ((size_t)(l * DECB + b) * 8) * 512 + h * 64;
                f32x4 o; float lse;
                dec_attn<3>(G_QA + (size_t)row * 512 + h * 64, IN(I_CAK) + cb, IN(I_CAV) + cb, out + O_AKS + nb, out + O_AVS + nb, 512, 2048, t, lane, o, lse);
                if (lane < 16) { u32x2 ow; ow.x = pk2(o[0], o[1]); ow.y = pk2(o[2], o[3]); *(u32x2*)(G_MIX + (size_t)row * DM + h * 64 + 4 * lane) = ow; }
            }
            for (int wt = gw; wt < DECB * DECS * 16; wt += NGW) {
                const int qh = wt & 15, t = (wt >> 4) & 7, b = wt >> 7; const int row = MP + b * 8 + t, kvh = qh >> 3;
                const size_t cb = ((size_t)(l * DECB + b) * 128) * 128 + kvh * 64, nb = ((size_t)(l * DECB + b) * 8) * 128 + kvh * 64;
                f32x4 o; float lse;
                dec_attn<1>(G_QC + (size_t)row * 1024 + qh * 64, IN(I_CCK) + cb, IN(I_CCV) + cb, out + O_CKS + nb, out + O_CVS + nb, 128, 128, t, lane, o, lse);
                const float sc = sigmoidf_(lse - IN(I_SINK)[l * 16 + qh]);
                if (lane < 16) { u32x2 ow; ow.x = pk2(o[0] * sc, o[1] * sc); ow.y = pk2(o[2] * sc, o[3] * sc); *(u32x2*)(G_MIX + (size_t)row * DM + 1024 + qh * 64 + 4 * lane) = ow; }
            }
            }
#endif
        }
#endif
        GRID_BAR();

#ifndef SKIP_M2
        _Pragma("unroll 1") for (int rep_ = 0; rep_ < REP_M2; ++rep_) {
            PHASE_BEGIN
#pragma unroll 4
            for (int it = gt; it < MP * 64; it += NGT) {
                const int dc = it & 7, h = (it >> 3) & 7, row = it >> 6;
                const float l0 = G_LSE[((size_t)0 * MP + row) * 8 + h], l1 = G_LSE[((size_t)1 * MP + row) * 8 + h], l2 = G_LSE[((size_t)2 * MP + row) * 8 + h];
                const float mx = fmaxf(l0, fmaxf(l1, l2)); float w0 = __builtin_amdgcn_exp2f(1.4426950408889634f * (l0 - mx)), w1 = __builtin_amdgcn_exp2f(1.4426950408889634f * (l1 - mx)), w2 = __builtin_amdgcn_exp2f(1.4426950408889634f * (l2 - mx)); const float inv = 1.0f / (w0 + w1 + w2); w0 *= inv; w1 *= inv; w2 *= inv;
                const size_t off = (size_t)row * 512 + h * 64 + dc * 8;
                const u32x4 ua = *(const u32x4*)(G_OA + off), ub = *(const u32x4*)(G_OA + (size_t)MP * 512 + off), uc = *(const u32x4*)(G_OA + (size_t)2 * MP * 512 + off);
#define BF_LO(x) __builtin_bit_cast(float, (x) << 16)
#define BF_HI(x) __builtin_bit_cast(float, (x) & 0xffff0000u)
                const f32x4 a0 = (f32x4){BF_LO(ua.x), BF_HI(ua.x), BF_LO(ua.y), BF_HI(ua.y)}, a1 = (f32x4){BF_LO(ua.z), BF_HI(ua.z), BF_LO(ua.w), BF_HI(ua.w)};
                const f32x4 b0 = (f32x4){BF_LO(ub.x), BF_HI(ub.x), BF_LO(ub.y), BF_HI(ub.y)}, b1 = (f32x4){BF_LO(ub.z), BF_HI(ub.z), BF_LO(ub.w), BF_HI(ub.w)};
                const f32x4 c0 = (f32x4){BF_LO(uc.x), BF_HI(uc.x), BF_LO(uc.y), BF_HI(uc.y)}, c1 = (f32x4){BF_LO(uc.z), BF_HI(uc.z), BF_LO(uc.w), BF_HI(uc.w)};
#undef BF_LO
#undef BF_HI
                const f32x4 r0 = a0 * w0 + b0 * w1 + c0 * w2, r1 = a1 * w0 + b1 * w1 + c1 * w2;
                u32x4 ow; ow.x = pk2(r0[0], r0[1]); ow.y = pk2(r0[2], r0[3]); ow.z = pk2(r1[0], r1[1]); ow.w = pk2(r1[2], r1[3]);
                *(u32x4*)(G_MIX + (size_t)row * DM + h * 64 + dc * 8) = ow;
            }
            LAS float* Sl = (LAS float*)lds;
            LAS float* Pl = (LAS float*)(lds + 17408);
            LAS float* PT = (LAS float*)(lds + 17408 + 20480 + wave * 8192);
            constexpr int PS = 80;
#pragma unroll 1
            for (int task = vcu; task < 256; task += G) {
                const int seg = task & 7, h = (task >> 3) & 7, b = task >> 6;
                const int th0 = (b * 8 + h) * SEQ + seg * 256, prow = b * SEQ + seg * 256;
                const int fi = tid >> 3, fj = (tid & 7) * 8;
                const int tr = wave >> 1, tc0 = (wave & 1) * 2, lr = lane & 15, lq = lane >> 4;
                const int nfold = seg;
                f32x4 pn0, pn1, zt0, zt1;
                __syncthreads();
                for (int i = tid; i < 64 * 68; i += 512) Sl[i] = 0.f;
#define FOLD_LOAD(c) do { const float* ze_ = G_ENDS + (size_t)(task - seg + (c)) * 8192; const float* pe_ = ze_ + 4096; \
                    pn0 = *(const f32x4*)(pe_ + tid * 8); pn1 = *(const f32x4*)(pe_ + tid * 8 + 4); \
                    _Pragma("unroll") for (int i_ = 0; i_ < 4; ++i_) { zt0[i_] = ze_[(tr * 16 + 4 * lq + i_) * 64 + tc0 * 16 + lr]; zt1[i_] = ze_[(tr * 16 + 4 * lq + i_) * 64 + tc0 * 16 + 16 + lr]; } } while (0)
#define FOLD_STEP(has_next, cn) do { \
                    __syncthreads(); \
                    *(LAS f32x4*)(Pl + fi * PS + fj) = pn0; *(LAS f32x4*)(Pl + fi * PS + fj + 4) = pn1; \
                    f32x4 a0 = zt0, a1 = zt1; \
                    __syncthreads(); \
                    if (has_next) FOLD_LOAD(cn); \
                    _Pragma("unroll") for (int kb = 0; kb < 16; ++kb) { \
                        const float av = Sl[(tr * 16 + lr) * 68 + kb * 4 + lq]; \
                        const float b0 = Pl[(kb * 4 + lq) * PS + tc0 * 16 + lr], b1 = Pl[(kb * 4 + lq) * PS + tc0 * 16 + 16 + lr]; \
                        a0 = __builtin_amdgcn_mfma_f32_16x16x4f32(av, b0, a0, 0, 0, 0); a1 = __builtin_amdgcn_mfma_f32_16x16x4f32(av, b1, a1, 0, 0, 0); } \
                    __syncthreads(); \
                    _Pragma("unroll") for (int i_ = 0; i_ < 4; ++i_) { Sl[(tr * 16 + 4 * lq + i_) * 68 + tc0 * 16 + lr] = a0[i_]; Sl[(tr * 16 + 4 * lq + i_) * 68 + tc0 * 16 + 16 + lr] = a1[i_]; } } while (0)
                if (nfold > 0) FOLD_LOAD(0);
#pragma unroll 1
                for (int c = 0; c < nfold; ++c) FOLD_STEP(c + 1 < nfold, c + 1);
                if (seg == 7) FOLD_LOAD(7);
                __syncthreads();
                {
                    const int tb = th0 + 32 * wave;
                    const float lw = IN(I_LNW)[l * 512 + h * 64 + lane], lb = IN(I_LNB)[l * 512 + h * 64 + lane];
                    if (seg > 0) {
#pragma unroll 16
                        for (int tk = 0; tk < 32; ++tk) PT[tk * 64 + lane] = G_YZ[(size_t)(tb + tk) * 128 + 64 + lane];
                        LDS_WAIT(); asm volatile("" ::: "memory");
                    }
                    float yv[4], bo[4], vv[4], gg[4], yn[4], bn[4], vn[4], gn[4];
#pragma unroll
                    for (int u = 0; u < 4; ++u) { const int th = tb + u; yv[u] = G_YZ[(size_t)th * 128 + lane]; bo[u] = G_BON[th]; vv[u] = G_OPS[(size_t)th * 384 + 320 + lane]; gg[u] = G_GG[(size_t)th * 64 + lane]; yn[u] = bn[u] = vn[u] = gn[u] = 0.f; }
#pragma unroll 1
                    for (int t4 = 0; t4 < 32; t4 += 4) {
                        if (t4 + 4 < 32) {
#pragma unroll
                            for (int u = 0; u < 4; ++u) { const int th = tb + t4 + 4 + u; yn[u] = G_YZ[(size_t)th * 128 + lane]; bn[u] = G_BON[th]; vn[u] = G_OPS[(size_t)th * 384 + 320 + lane]; gn[u] = G_GG[(size_t)th * 64 + lane]; }
                        }
#pragma unroll
                        for (int u = 0; u < 4; ++u) {
                            float y = yv[u];
                            if (seg > 0) {
                                float y2 = 0.f;
#pragma unroll
                                for (int q = 0; q < 16; ++q) { const f32x4 p4 = *(const LAS f32x4*)(PT + (t4 + u) * 64 + 4 * q), s4 = *(const LAS f32x4*)(Sl + lane * 68 + 4 * q); y += s4[0] * p4[0] + s4[1] * p4[1]; y2 += s4[2] * p4[2] + s4[3] * p4[3]; }
                                y += y2;
                            }
                            rwkv_out_token(y, lw, lb, bo[u], vv[u], gg[u], G_MIX + (size_t)(prow + 32 * wave + t4 + u) * DM + 512 + h * 64 + lane);
                        }
#pragma unroll
                        for (int u = 0; u < 4; ++u) { yv[u] = yn[u]; bo[u] = bn[u]; vv[u] = vn[u]; gg[u] = gn[u]; }
                    }
                }
                if (seg == 7) { FOLD_STEP(false, 0); __syncthreads(); float* wo = out + O_WKVP + ((size_t)(l * NBATCH + b) * 8 + h) * 4096 + fi * 64 + fj; *(f32x4*)wo = *(const LAS f32x4*)(Sl + fi * 68 + fj); *(f32x4*)(wo + 4) = *(const LAS f32x4*)(Sl + fi * 68 + fj + 4); }
#undef FOLD_STEP
#undef FOLD_LOAD
            }
            __syncthreads();
            if (rep_ == 0) {
                const int seg = vcu & 7, grp = vcu >> 3;
                const int cn = (int)((0x5080a0d0f1213ull >> (8 * seg)) & 0xffu), co = (int)((0x58534b4134251300ull >> (8 * seg)) & 0xffu);
                LAS unsigned char* scr = lds + wave * 16384;
                for (int j = wave; j < cn; j += 8) { const int it = IT_B / 2 + grp * 88 + co + j; CONV_ITEM_B(l, it); }
                __syncthreads();
            }
            {
                const int task = vcu, seg = task & 7, bh = task >> 3;
                int kslice = 512; asm volatile("" : "+s"(kslice));
                const int pn = bh & 7, ks = bh >> 3;
                pg8::OneUnit S2; S2.pm = 0; S2.pn = pn; S2.have = (rep_ == 0) && seg == 0;
                pg8::Gemm g2{G_MIX + (size_t)MP * DM + ks * 512, G_WOUT + (size_t)l * DM * DM + ks * 512, MS, DM, kslice, DM};
                pg8::EpiPart E2; E2.P = G_PART + (size_t)ks * MS * DM;
                pg8::gemm_phase<pg8::EpiPart, pg8::OneUnit, true, true>(lds, g2, S2, E2, wave);
            }
        }
#endif
        GRID_BAR();

#ifndef SKIP_POUT
        _Pragma("unroll 1") for (int rep_ = 0; rep_ < REP_POUT; ++rep_) {
            PHASE_BEGIN
            if (rep_ == 0) {
                const int row = MP + vcu; const int c = 256 * wave + 4 * lane;
                f32x4 v = l == 0 ? *(const f32x4*)(IN(I_XS) + (size_t)vcu * DM + c) : *(const f32x4*)(G_X + (size_t)row * DM + c);
                const f32x4 p0 = *(const f32x4*)(G_PART + ((size_t)0 * MS + vcu) * DM + c), p1 = *(const f32x4*)(G_PART + ((size_t)1 * MS + vcu) * DM + c);
                const f32x4 p2 = *(const f32x4*)(G_PART + ((size_t)2 * MS + vcu) * DM + c), p3 = *(const f32x4*)(G_PART + ((size_t)3 * MS + vcu) * DM + c);
                v += (p0 + p1) + (p2 + p3);
                *(f32x4*)(G_X + (size_t)row * DM + c) = v; u32x2 o; o.x = pk2(v[0], v[1]); o.y = pk2(v[2], v[3]); *(u32x2*)(G_XN + (size_t)row * DM + c) = o;
                const float s = wave_sum((v[0] * v[0] + v[1] * v[1]) + (v[2] * v[2] + v[3] * v[3]));
                if (lane == 0) unsafeAtomicAdd(G_SSQ + (size_t)(2 * l + 1) * MTOT + row, s);
            }
            pg8::Gemm g{G_MIX, G_WOUT + (size_t)l * DM * DM, MP, DM, DM, DM}; pg8::StaticOrder S; S.init(MP, DM, G, bx);
            pg8::EpiRes E; E.X = G_X; E.Xin = l == 0 ? IN(I_XP) : G_X; E.XN = G_XN; E.ssq_next = G_SSQ + (size_t)(2 * l + 1) * MTOT; E.dry = (rep_ + 1 < REP_POUT);
            pg8::gemm_phase<pg8::EpiRes, pg8::StaticOrder, true, true>(lds, g, S, E, wave);
        }
#endif
        GRID_BAR();
#ifndef SKIP_PGU
        _Pragma("unroll 1") for (int rep_ = 0; rep_ < REP_PGU; ++rep_) {
            PHASE_BEGIN
            pg8::Gemm g{G_XN, G_WGU + (size_t)l * NGU * DM, MTOT, NGU, DM, DM}; pg8::GuOrder S; S.init(G, bx);
            pg8::EpiGU E; E.ssq = G_SSQ + (size_t)(2 * l + 1) * MTOT; E.ACT = G_ACT;
            pg8::gemm_phase<pg8::EpiGU, pg8::GuOrder, true, true>(lds, g, S, E, wave);
            if (bx >= pg8::GuOrder::SPEC0 && rep_ == 0) {
                const int k = bx - pg8::GuOrder::SPEC0;
                int kslice = 256; asm volatile("" : "+s"(kslice));
                pg8::Gemm g2{G_ACT + (size_t)MP * FF + k * 256, G_WDN + (size_t)l * DM * FF + k * 256, MS, DM, kslice, FF};
                pg8::RowUnits S2; S2.nt = DM / 256; S2.have = true;
                pg8::EpiPart E2; E2.P = G_PART + (size_t)k * MS * DM;
                pg8::gemm_phase<pg8::EpiPart, pg8::RowUnits, true, true>(lds, g2, S2, E2, wave);
            }
        }
#endif
        GRID_BAR();
#ifndef SKIP_PDN
        _Pragma("unroll 1") for (int rep_ = 0; rep_ < REP_PDN; ++rep_) {
            PHASE_BEGIN
            if (rep_ == 0) {
                const int row = MP + vcu; const int c = 256 * wave + 4 * lane;
                f32x4 v = *(const f32x4*)(G_X + (size_t)row * DM + c);
                f32x4 pp[22];
#pragma unroll
                for (int kc = 0; kc < 22; ++kc) pp[kc] = *(const f32x4*)(G_PART + ((size_t)kc * MS + vcu) * DM + c);
#pragma unroll
                for (int kc = 0; kc < 22; ++kc) v += pp[kc];
                float s = wave_sum((v[0] * v[0] + v[1] * v[1]) + (v[2] * v[2] + v[3] * v[3]));
                if (l + 1 < DEPTH || G != 256) {
                    *(f32x4*)(G_X + (size_t)row * DM + c) = v; u32x2 o; o.x = pk2(v[0], v[1]); o.y = pk2(v[2], v[3]); *(u32x2*)(G_XN + (size_t)row * DM + c) = o;
                    if (lane == 0) unsafeAtomicAdd(G_SSQ + (size_t)(2 * l + 2) * MTOT + row, s);
                } else {
                    volatile LAS float* sl = (volatile LAS float*)(lds + MISC_OFF + 128);
                    if (lane == 0) sl[wave] = s;
                    __syncthreads();
                    const float tot = ((sl[0] + sl[1]) + (sl[2] + sl[3])) + ((sl[4] + sl[5]) + (sl[6] + sl[7]));
                    const float rstd = rsqrtf(tot * (1.0f / DM) + RMS_EPS);
                    *(f32x4*)(out + (size_t)row * DM + c) = v * rstd * *(const f32x4*)(IN(I_GFIN) + c);
                    __syncthreads();
                }
            }
            pg8::Gemm g{G_ACT, G_WDN + (size_t)l * DM * FF, MP, DM, FF, FF}; pg8::StaticOrder S; S.init(MP, DM, G, bx);
            if (l + 1 < DEPTH || G != 256) {
                pg8::EpiRes E; E.X = G_X; E.Xin = G_X; E.XN = G_XN; E.ssq_next = G_SSQ + (size_t)(2 * l + 2) * MTOT; E.dry = (rep_ + 1 < REP_PDN);
                pg8::gemm_phase<pg8::EpiRes, pg8::StaticOrder, true, true>(lds, g, S, E, wave);
            } else {
                pg8::EpiFinal E; E.X = G_X; E.OUT = out; E.gf = IN(I_GFIN); E.ssq = G_SSQ + (size_t)(2 * DEPTH) * MTOT; E.cnt = (unsigned*)(ws + WS_CTL) + CW_FIN;
                pg8::gemm_phase<pg8::EpiFinal, pg8::StaticOrder, true, true>(lds, g, S, E, wave);
            }
        }
#endif
        if (l + 1 < DEPTH || G != 256) GRID_BAR();
    }
    if (G != 256) {
        PHASE_BEGIN
        const float* ssq = G_SSQ + (size_t)(2 * DEPTH) * MTOT; const float* gf = IN(I_GFIN);
        for (int m = gw; m < MTOT; m += NGW) {
            const float rstd = rsqrtf(ssq[m] * (1.0f / DM) + RMS_EPS);
#pragma unroll
            for (int j = 0; j < 8; ++j) { const int c = 4 * lane + 256 * j; const f32x4 v = *(const f32x4*)(G_X + (size_t)m * DM + c), gg = *(const f32x4*)(gf + c);
                *(f32x4*)(out + (size_t)m * DM + c) = v * rstd * gg; }
        }
    }
}

extern "C" void kernel_launch(void* const* d_in, const int* in_sizes, int n_in, void* d_out, int out_size, void* d_ws, size_t ws_size, hipStream_t stream) {
    static int grid = 0;
    if (grid == 0) {
        if (n_in != 28 || (size_t)out_size != O_END || ws_size < WS_END) { fprintf(stderr, "kernel_launch: unexpected shapes: n_in %d out %d (want %zu) ws %zu (want >= %zu)\n", n_in, out_size, (size_t)O_END, ws_size, (size_t)WS_END); grid = -1; return; }
        int dev = 0, cus = 0;
        if (hipGetDevice(&dev) != hipSuccess || hipDeviceGetAttribute(&cus, hipDeviceAttributeMultiprocessorCount, dev) != hipSuccess) { grid = -1; return; }
        if (hipFuncSetAttribute((const void*)fwd, hipFuncAttributeMaxDynamicSharedMemorySize, LDS_BYTES) != hipSuccess) { fprintf(stderr, "kernel_launch: hipFuncSetAttribute failed\n"); grid = -1; return; }
        int per_cu = 0;
        if (hipOccupancyMaxActiveBlocksPerMultiprocessor(&per_cu, (const void*)fwd, 512, LDS_BYTES) != hipSuccess || per_cu < 1) { fprintf(stderr, "kernel_launch: occupancy query says %d blocks per CU\n", per_cu); }
        (void)hipGetLastError();
        grid = cus;
    }
    if (grid < 0) return;
    if (hipMemsetAsync((char*)d_ws + WS_CTL, 0, CTL_ZERO_BYTES, stream) != hipSuccess) return;
    Args a{};
    for (int i = 0; i < 28; ++i) a.in[i] = (const float*)d_in[i];
    a.out = (float*)d_out; a.ws = (unsigned char*)d_ws;
    hipLaunchKernelGGL(fwd, dim3(grid), dim3(512), LDS_BYTES, stream, a);
}
```

```cpp
#include <hip/hip_runtime.h>
#include <cstdio>
#include <cstdint>

constexpr int DM = 2048, SEQ = 2048, NBATCH = 4, MP = NBATCH * SEQ, DECB = 32, DECS = 8, MS = DECB * DECS, MTOT = MP + MS;
constexpr int DEPTH = 4, BCOLS = 1792, INC = 4608, FF = 5632, NGU = 2 * FF;
constexpr int PASTLEN = 16384;
constexpr float RMS_EPS = 1e-6f, GN_EPS = 64e-5f;
constexpr float QSCALE = 0.125f * 1.4426950408889634f;
constexpr float LN2F = 0.6931471805599453f;
namespace pg8 {
#define PG8_LAS __attribute__((address_space(3)))
typedef unsigned short bf16_t;
typedef short bf16x8 __attribute__((ext_vector_type(8)));
typedef float f32x4 __attribute__((ext_vector_type(4)));
typedef unsigned u32x4 __attribute__((ext_vector_type(4)));
constexpr int BM = 256, BK = 64, HALF = 128, HTB = HALF * BK * 2  , STAGE_BYTES = 8 * HTB, NXCD = 8, WGM = 8;

__host__ __device__ __forceinline__ int lds_byte(int r, int c) { const int st = (r >> 4) * 2 + (c >> 5), rr = r & 15, cc = c & 31, ob = rr * 64 + cc * 2; return st * 1024 + (ob ^ (((ob >> 9) & 1) << 5)); }
__host__ __device__ __forceinline__ void stage_rc(int b, int& R, int& C) { const int st = b / 1024, sb = b % 1024, swz = sb ^ (((sb >> 9) & 1) << 5); R = (st >> 1) * 16 + swz / 64; C = (st & 1) * 32 + (swz % 64) / 2; }
__host__ __device__ __forceinline__ int perm32(int rho) { const int n = rho >> 4, i = rho & 15; return 8 * (i >> 2) + 4 * n + (i & 3); }

struct Unit { int pm, pn; };
struct Gemm { const bf16_t* A; const bf16_t* Bt; int M, N, K, ld; };

struct StaticOrder {
    int nM, nN, nwg, G, c;
    __host__ __device__ void init(int M, int N, int G_, int c_) { nM = M / BM; nN = N / BM; nwg = nM * nN; G = G_; c = c_; }
    __host__ __device__ bool unit_at(long L, Unit& u) const {
        if (L >= nwg) return false;
        int wgid = (int)L; { const int q = nwg / NXCD, r = nwg % NXCD, xcd = wgid % NXCD, off = wgid / NXCD; wgid = (xcd < r ? xcd * (q + 1) : r * (q + 1) + (xcd - r) * q) + off; }
        const int nig = WGM * nN, gid = wgid / nig, fm = gid * WGM, gsz = (nM - fm) < WGM ? (nM - fm) : WGM;
        u.pm = fm + ((wgid % nig) % gsz); u.pn = (wgid % nig) / gsz; return true;
    }
    __host__ __device__ bool next(int i, Unit& u) const { return unit_at((long)i * G + c, u); }
    __device__ __forceinline__ void a_ready(const Unit&) const {}
    __device__ __forceinline__ void done(const Unit&) const {}
};


struct GuOrder {
    StaticOrder so; int c;
    static constexpr int MP_ROWS = 8192, SPEC0 = 234;
    __host__ __device__ void init(int G_, int c_) { so.init(MP_ROWS, 2 * 5632, G_, c_); c = c_; }
    __host__ __device__ bool next(int i, Unit& u) const {
        if (c >= SPEC0) { const int k = c - SPEC0;
            if (i < 1) return so.unit_at((long)c, u);
            if (i < 3) { u.pm = MP_ROWS / 256; u.pn = 2 * k + (i - 1); return true; }
            return false; }
        const int np = c < 128 ? 6 : 5;
        if (i < np) return so.unit_at((long)i * 256 + c, u);
        if (i == 5 && c < 216) { const int j = c - 128; return so.unit_at(256 + 256 * (j / 22) + SPEC0 + (j % 22), u); }
        return false;
    }
    __device__ __forceinline__ void a_ready(const Unit&) const {}
    __device__ __forceinline__ void done(const Unit&) const {}
};
struct RowUnits {
    int nt; bool have;
    __host__ __device__ bool next(int i, Unit& u) const { if (!have || i >= nt) return false; u.pm = 0; u.pn = i; return true; }
    __device__ __forceinline__ void a_ready(const Unit&) const {}
    __device__ __forceinline__ void done(const Unit&) const {}
};
struct OneUnit {
    int pm = 0, pn; bool have;
    __host__ __device__ bool next(int i, Unit& u) const { if (i != 0 || !have) return false; u.pm = pm; u.pn = pn; return true; }
    __device__ __forceinline__ void a_ready(const Unit&) const {}
    __device__ __forceinline__ void done(const Unit&) const {}
};
__device__ __forceinline__ unsigned cvt_pk_bf16(float lo, float hi) { unsigned r; asm volatile("v_cvt_pk_bf16_f32 %0, %1, %2" : "=v"(r) : "v"(lo), "v"(hi)); return r; }
__device__ __forceinline__ void st_bf16x8(bf16_t* p, const f32x4 a, const f32x4 b) { u32x4 w; w.x = cvt_pk_bf16(a[0], a[1]); w.y = cvt_pk_bf16(a[2], a[3]); w.z = cvt_pk_bf16(b[0], b[1]); w.w = cvt_pk_bf16(b[2], b[3]); *(u32x4*)p = w; }
__device__ __forceinline__ void st_f32x8(float* p, const f32x4 a, const f32x4 b) { *(f32x4*)p = a; *(f32x4*)(p + 4) = b; }

struct EpiIn {
    static constexpr bool PERM = true, AFTER_DRAIN = false;
    const float* ssq; const float* rope;
    bf16_t *QA, *KA, *VA, *QC, *KC, *VC; float* PB;
    float *o_ak_p, *o_av_p, *o_ck_p, *o_cv_p, *o_sh_p, *o_ak_s, *o_av_s, *o_ck_s, *o_cv_s, *o_sh_s;
    template <int TY> __device__ __forceinline__ void run(const f32x4 (&acc)[2][2][4][2], const Unit& u, int wr, int wc, int fr, int fq) const {
        const int pn = u.pn; const bool isS = (u.pm == MP / 256);
        const int cl = wc * 32 + fq * 8;
        float rs[2][4];
#pragma unroll
        for (int ai = 0; ai < 2; ++ai)
#pragma unroll
            for (int m = 0; m < 4; ++m) rs[ai][m] = ssq[u.pm * 256 + ai * 128 + wr * 64 + m * 16 + fr];
#pragma unroll
        for (int ai = 0; ai < 2; ++ai)
#pragma unroll
            for (int m = 0; m < 4; ++m) {
                const int row = u.pm * 256 + ai * 128 + wr * 64 + m * 16 + fr;
                const float rstd = rsqrtf(rs[ai][m] * (1.0f / DM) + RMS_EPS);
                int b, t, pidx;
                if (!isS) { b = row >> 11; t = row & 2047; pidx = t; } else { const int r = row - MP; b = r >> 3; t = r & 7; pidx = SEQ + t; }
#pragma unroll
                for (int bj = 0; bj < 2; ++bj) {
                    f32x4 v0 = acc[ai][bj][m][0] * rstd, v1 = acc[ai][bj][m][1] * rstd;
                    const int c = bj * 128 + cl;
                    const bool roped = (TY == 0 || TY == 1 || TY == 4 || (TY == 5 && bj == 0));
                    if (roped && (wc & 1) == 0) {
                        f32x4 p0, p1;
#pragma unroll
                        for (int j = 0; j < 4; ++j) { p0[j] = __shfl_xor(v0[j], 16); p1[j] = __shfl_xor(v1[j], 16); }
                        const float* rp = rope + pidx * 16;
                        const f32x4 c0 = *(const f32x4*)rp, c1 = *(const f32x4*)(rp + 4), s0 = *(const f32x4*)(rp + 8), s1 = *(const f32x4*)(rp + 12);
                        if (fq == 0) { v0 = v0 * c0 - p0 * s0; v1 = v1 * c1 - p1 * s1; }
                        else if (fq == 1) { v0 = v0 * c0 + p0 * s0; v1 = v1 * c1 + p1 * s1; }
                    }
                    if (TY == 0) { st_bf16x8(QA + (size_t)row * 512 + pn * 256 + c, v0 * QSCALE, v1 * QSCALE); }
                    if (TY == 1) { st_bf16x8(KA + (size_t)row * 512 + (pn - 2) * 256 + c, v0, v1);
                        float* o = (isS ? o_ak_s + (size_t)(row - MP) * 512 : o_ak_p + (size_t)row * 512) + (pn - 2) * 256 + c; st_f32x8(o, v0, v1); }
                    if (TY == 2) { st_bf16x8(VA + (size_t)row * 512 + (pn - 4) * 256 + c, v0, v1);
                        float* o = (isS ? o_av_s + (size_t)(row - MP) * 512 : o_av_p + (size_t)row * 512) + (pn - 4) * 256 + c; st_f32x8(o, v0, v1); }
                    if (TY == 3) { const int cc = (pn - 6) * 256 + c; st_f32x8(PB + (size_t)row * BCOLS + cc, v0, v1);
                        if (!isS && t == SEQ - 1) st_f32x8(o_sh_p + b * BCOLS + cc, v0, v1);
                        if (isS && t == DECS - 1) st_f32x8(o_sh_s + b * BCOLS + cc, v0, v1); }
                    if (TY == 4) { st_bf16x8(QC + (size_t)row * 1024 + (pn - 13) * 256 + c, v0 * QSCALE, v1 * QSCALE); }
                    if (TY == 5) {
                        bf16_t* dst = (bj == 0 ? KC : VC) + (size_t)row * 128 + cl; st_bf16x8(dst, v0, v1);
                        float* op = bj == 0 ? o_ck_p : o_cv_p; float* os = bj == 0 ? o_ck_s : o_cv_s;
                        if (isS) st_f32x8(os + (size_t)(row - MP) * 128 + cl, v0, v1);
                        else if (t >= SEQ - 128) st_f32x8(op + (size_t)(b * 128 + t - (SEQ - 128)) * 128 + cl, v0, v1);
                    }
                }
                asm volatile("" ::: "memory");
            }
    }
    __device__ __forceinline__ void operator()(const f32x4 (&acc)[2][2][4][2], const Unit& u, int wr, int wc, int fr, int fq) const {
        asm volatile("" : "+v"(fr), "+v"(fq));
        const int pn = u.pn;
        if (pn < 2) run<0>(acc, u, wr, wc, fr, fq);
        else if (pn < 4) run<1>(acc, u, wr, wc, fr, fq);
        else if (pn < 6) run<2>(acc, u, wr, wc, fr, fq);
        else if (pn < 13) run<3>(acc, u, wr, wc, fr, fq);
        else if (pn < 17) run<4>(acc, u, wr, wc, fr, fq);
        else run<5>(acc, u, wr, wc, fr, fq);
        asm volatile("s_waitcnt vmcnt(0)" ::: "memory");
    }
};
struct EpiRes {
    static constexpr bool PERM = true, AFTER_DRAIN = false;
    float* X; const float* Xin; bf16_t* XN; float* ssq_next; int dry;
    __device__ __forceinline__ void operator()(const f32x4 (&acc)[2][2][4][2], const Unit& u, int wr, int wc, int fr, int fq) const {
        asm volatile("" : "+v"(fr), "+v"(fq));
        const int cl = u.pn * 256 + wc * 32 + fq * 8;
        f32x4 xc[2][2], xn[2][2];
        { const float* xp = Xin + (size_t)(u.pm * 256 + wr * 64 + fr) * DM + cl;
          xc[0][0] = *(const f32x4*)xp; xc[0][1] = *(const f32x4*)(xp + 4); xc[1][0] = *(const f32x4*)(xp + 128); xc[1][1] = *(const f32x4*)(xp + 132); }
        xn[0][0] = xn[0][1] = xn[1][0] = xn[1][1] = (f32x4){0.f, 0.f, 0.f, 0.f};
#pragma unroll
        for (int ai = 0; ai < 2; ++ai)
#pragma unroll
            for (int m = 0; m < 4; ++m) {
                const int row = u.pm * 256 + ai * 128 + wr * 64 + m * 16 + fr; float s = 0.f;
                if (!(ai == 1 && m == 3)) { const int g1 = ai * 4 + m + 1; const float* xp = Xin + (size_t)(u.pm * 256 + (g1 >> 2) * 128 + wr * 64 + (g1 & 3) * 16 + fr) * DM + cl;
                    xn[0][0] = *(const f32x4*)xp; xn[0][1] = *(const f32x4*)(xp + 4); xn[1][0] = *(const f32x4*)(xp + 128); xn[1][1] = *(const f32x4*)(xp + 132); }
#pragma unroll
                for (int bj = 0; bj < 2; ++bj) {
                    float* xp = X + (size_t)row * DM + cl + bj * 128;
                    const f32x4 x0 = xc[bj][0] + acc[ai][bj][m][0], x1 = xc[bj][1] + acc[ai][bj][m][1];
                    if (!dry) { st_f32x8(xp, x0, x1); st_bf16x8(XN + (size_t)row * DM + cl + bj * 128, x0, x1); }
                    s += (x0[0] * x0[0] + x0[1] * x0[1]) + (x0[2] * x0[2] + x0[3] * x0[3]) + (x1[0] * x1[0] + x1[1] * x1[1]) + (x1[2] * x1[2] + x1[3] * x1[3]);
                }
                s += __shfl_xor(s, 16); s += __shfl_xor(s, 32);
                if (fq == 0 && !dry) unsafeAtomicAdd(ssq_next + row, s);
                asm volatile("" ::: "memory");
                xc[0][0] = xn[0][0]; xc[0][1] = xn[0][1]; xc[1][0] = xn[1][0]; xc[1][1] = xn[1][1];
            }
    }
};
struct EpiFinal {
    static constexpr bool PERM = true, AFTER_DRAIN = true;
    const float* X; float* OUT; const float* gf; float* ssq; unsigned* cnt;
    __device__ __forceinline__ void fused(const f32x4 (&acc)[2][2][4][2], const Unit& u, int wr, int wc, int fr, int fq, PG8_LAS unsigned char*, int wid, int lane) const {
        asm volatile("" : "+v"(fr), "+v"(fq));
        const int cl = u.pn * 256 + wc * 32 + fq * 8;
        f32x4 xv[2][4][2][2];
        f32x4 xc[2][2], xn[2][2];
        { const float* xp = X + (size_t)(u.pm * 256 + wr * 64 + fr) * DM + cl;
          xc[0][0] = *(const f32x4*)xp; xc[0][1] = *(const f32x4*)(xp + 4); xc[1][0] = *(const f32x4*)(xp + 128); xc[1][1] = *(const f32x4*)(xp + 132); }
        xn[0][0] = xn[0][1] = xn[1][0] = xn[1][1] = (f32x4){0.f, 0.f, 0.f, 0.f};
#pragma unroll
        for (int ai = 0; ai < 2; ++ai)
#pragma unroll
            for (int m = 0; m < 4; ++m) {
                const int row = u.pm * 256 + ai * 128 + wr * 64 + m * 16 + fr; float s = 0.f;
                if (!(ai == 1 && m == 3)) { const int g1 = ai * 4 + m + 1; const float* xp = X + (size_t)(u.pm * 256 + (g1 >> 2) * 128 + wr * 64 + (g1 & 3) * 16 + fr) * DM + cl;
                    xn[0][0] = *(const f32x4*)xp; xn[0][1] = *(const f32x4*)(xp + 4); xn[1][0] = *(const f32x4*)(xp + 128); xn[1][1] = *(const f32x4*)(xp + 132); }
#pragma unroll
                for (int bj = 0; bj < 2; ++bj) {
                    const f32x4 x0 = xc[bj][0] + acc[ai][bj][m][0], x1 = xc[bj][1] + acc[ai][bj][m][1];
                    xv[ai][m][bj][0] = x0; xv[ai][m][bj][1] = x1;
                    s += (x0[0] * x0[0] + x0[1] * x0[1]) + (x0[2] * x0[2] + x0[3] * x0[3]) + (x1[0] * x1[0] + x1[1] * x1[1]) + (x1[2] * x1[2] + x1[3] * x1[3]);
                }
                s += __shfl_xor(s, 16); s += __shfl_xor(s, 32);
                if (fq == 0) (void)__hip_atomic_fetch_add(ssq + row, s, __ATOMIC_RELAXED, __HIP_MEMORY_SCOPE_AGENT);
                asm volatile("" ::: "memory");
                xc[0][0] = xn[0][0]; xc[0][1] = xn[0][1]; xc[1][0] = xn[1][0]; xc[1][1] = xn[1][1];
            }
        asm volatile("s_waitcnt vmcnt(0)" ::: "memory");
        __syncthreads();
        if (wid == 0 && lane == 0) {
            unsigned long long ci_ = (unsigned long long)(cnt + u.pm * 32); asm volatile("" : "+v"(ci_)); unsigned* cp = (unsigned*)(__attribute__((address_space(1))) unsigned*)ci_;
            (void)__hip_atomic_fetch_add(cp, 1u, __ATOMIC_RELAXED, __HIP_MEMORY_SCOPE_AGENT);
            unsigned sp = 0; while (__hip_atomic_load(cp, __ATOMIC_RELAXED, __HIP_MEMORY_SCOPE_AGENT) < 8u) { __builtin_amdgcn_s_sleep(1); if (++sp > (1u << 22)) break; }
        }
        __syncthreads();
        float rs[2][4];
#pragma unroll
        for (int ai = 0; ai < 2; ++ai)
#pragma unroll
            for (int m = 0; m < 4; ++m) rs[ai][m] = __hip_atomic_load(ssq + u.pm * 256 + ai * 128 + wr * 64 + m * 16 + fr, __ATOMIC_RELAXED, __HIP_MEMORY_SCOPE_AGENT);
        f32x4 gg[2][2];
#pragma unroll
        for (int bj = 0; bj < 2; ++bj) { gg[bj][0] = *(const f32x4*)(gf + cl + bj * 128); gg[bj][1] = *(const f32x4*)(gf + cl + bj * 128 + 4); }
#pragma unroll
        for (int ai = 0; ai < 2; ++ai)
#pragma unroll
            for (int m = 0; m < 4; ++m) {
                const int row = u.pm * 256 + ai * 128 + wr * 64 + m * 16 + fr;
                const float rstd = rsqrtf(rs[ai][m] * (1.0f / DM) + RMS_EPS);
#pragma unroll
                for (int bj = 0; bj < 2; ++bj) st_f32x8(OUT + (size_t)row * DM + cl + bj * 128, xv[ai][m][bj][0] * rstd * gg[bj][0], xv[ai][m][bj][1] * rstd * gg[bj][1]);
                asm volatile("" ::: "memory");
            }
    }
};
struct EpiPart {
    static constexpr bool PERM = true, AFTER_DRAIN = false;
    float* P;
    __device__ __forceinline__ void operator()(const f32x4 (&acc)[2][2][4][2], const Unit& u, int wr, int wc, int fr, int fq) const {
        asm volatile("" : "+v"(fr), "+v"(fq));
        const int cl = u.pn * 256 + wc * 32 + fq * 8;
#pragma unroll
        for (int ai = 0; ai < 2; ++ai)
#pragma unroll
            for (int m = 0; m < 4; ++m) {
                const int row = ai * 128 + wr * 64 + m * 16 + fr;
#pragma unroll
                for (int bj = 0; bj < 2; ++bj) st_f32x8(P + (size_t)row * DM + cl + bj * 128, acc[ai][bj][m][0], acc[ai][bj][m][1]);
            }
    }
};
struct EpiGU {
    static constexpr bool PERM = true, AFTER_DRAIN = false;
    const float* ssq; bf16_t* ACT;
    __device__ __forceinline__ void operator()(const f32x4 (&acc)[2][2][4][2], const Unit& u, int wr, int wc, int fr, int fq) const {
        asm volatile("" : "+v"(fr), "+v"(fq));
        const int cl = u.pn * 128 + wc * 32 + fq * 8;
        float rs[2][4];
#pragma unroll
        for (int ai = 0; ai < 2; ++ai)
#pragma unroll
            for (int m = 0; m < 4; ++m) rs[ai][m] = ssq[u.pm * 256 + ai * 128 + wr * 64 + m * 16 + fr];
#pragma unroll
        for (int ai = 0; ai < 2; ++ai)
#pragma unroll
            for (int m = 0; m < 4; ++m) {
                const int row = u.pm * 256 + ai * 128 + wr * 64 + m * 16 + fr;
                const float rstd = rsqrtf(rs[ai][m] * (1.0f / DM) + RMS_EPS);
                f32x4 o[2];
#pragma unroll
                for (int n = 0; n < 2; ++n) {
                    const f32x4 g = acc[ai][0][m][n] * rstd, up = acc[ai][1][m][n] * rstd;
#pragma unroll
                    for (int j = 0; j < 4; ++j) o[n][j] = g[j] * __builtin_amdgcn_rcpf(1.0f + __builtin_amdgcn_exp2f(-1.4426950408889634f * g[j])) * up[j];
                }
                st_bf16x8(ACT + (size_t)row * FF + cl, o[0], o[1]);
                asm volatile("" ::: "memory");
            }
    }
};

template <class Epi, class Sched, bool ALIGN_EPI = false, bool SP2 = false>
__device__ __forceinline__ void gemm_phase(PG8_LAS unsigned char* lds, const Gemm g, const Sched& S, const Epi& E, const int wave_id) {
    int lane_; asm volatile("v_mbcnt_lo_u32_b32 %0, -1, 0\n\tv_mbcnt_hi_u32_b32 %0, -1, %0" : "=v"(lane_));
    const int wid = wave_id, lane = lane_, tid = wid * 64 + lane, wr = wid >> 2, wc = wid & 3, fr = lane & 15, fq = lane >> 4;
    const int K = g.K, nt = K / BK;
    unsigned voffA[2], voffB[2];
#pragma unroll
    for (int i = 0; i < 2; ++i) { int R, C; stage_rc(tid * 16 + i * 8192, R, C); const int Rb = Epi::PERM ? ((R & ~31) + perm32(R & 31)) : R;
        voffA[i] = (unsigned)(R * g.ld + C) * 2u; voffB[i] = (unsigned)(Rb * g.ld + C) * 2u; }
    const size_t kstep = (size_t)(BK * 2);
    const size_t hstep = (size_t)HALF * g.ld * 2;
    const size_t tstep = 2 * hstep;
    const unsigned ldsw = (unsigned)wid * 1024u;
    const int aoff = lds_byte(wr * 64 + fr, fq * 8), boff = lds_byte(wc * 32 + fr, fq * 8);
#define PG8_SA(b, h) (((b) * 2 + (h)) * HTB)
#define PG8_SB(b, h) ((4 + (b) * 2 + (h)) * HTB)
#define PG8_STAGE(bufoff, gbase, voff) do { _Pragma("unroll") for (int _i = 0; _i < 2; ++_i) \
        __builtin_amdgcn_global_load_lds((const unsigned*)((const char*)(gbase) + (voff)[_i]), (PG8_LAS unsigned*)(lds + (bufoff) + ldsw + _i * 8192), 16, 0, 0); } while (0)
#define PG8_LDA(dst, b, h) do { _Pragma("unroll") for (int m = 0; m < 4; ++m) _Pragma("unroll") for (int k = 0; k < 2; ++k) dst[m][k] = *(const PG8_LAS bf16x8*)(lds + PG8_SA(b, h) + aoff + m * 2048 + k * 1024); } while (0)
#define PG8_LDB(dst, b, h) do { _Pragma("unroll") for (int n = 0; n < 2; ++n) _Pragma("unroll") for (int k = 0; k < 2; ++k) dst[n][k] = *(const PG8_LAS bf16x8*)(lds + PG8_SB(b, h) + boff + n * 2048 + k * 1024); } while (0)
#define PG8_MMA(ai, bj, At, Bt) do { __builtin_amdgcn_s_setprio(1); _Pragma("unroll") for (int m = 0; m < 4; ++m) _Pragma("unroll") for (int n = 0; n < 2; ++n) _Pragma("unroll") for (int k = 0; k < 2; ++k) \
        acc[ai][bj][m][n] = __builtin_amdgcn_mfma_f32_16x16x32_bf16(Bt[n][k], At[m][k], acc[ai][bj][m][n], 0, 0, 0); __builtin_amdgcn_s_setprio(0); } while (0)
#define PG8_WAIT_V(n) asm volatile("s_waitcnt vmcnt(" #n ")" ::: "memory")
#define PG8_WAIT_L(n) asm volatile("s_waitcnt lgkmcnt(" #n ")" ::: "memory")
#define PG8_BAR __builtin_amdgcn_s_barrier()
#define PG8_SCHED __builtin_amdgcn_sched_barrier(0)
    Unit cur, nxt; int ui = 0;
    if (!S.next(0, cur)) return;
    f32x4 acc[2][2][4][2];
#pragma unroll
    for (int a = 0; a < 2; ++a)
#pragma unroll
        for (int b = 0; b < 2; ++b)
#pragma unroll
            for (int m = 0; m < 4; ++m)
#pragma unroll
                for (int n = 0; n < 2; ++n) acc[a][b][m][n] = (f32x4){0.f, 0.f, 0.f, 0.f};
    bf16x8 At[4][2], B0[2][2], B1[2][2];
    const char* cA = (const char*)g.A + (size_t)cur.pm * tstep; const char* cB = (const char*)g.Bt + (size_t)cur.pn * tstep;
    S.a_ready(cur);
    if constexpr (SP2) {
        PG8_STAGE(PG8_SB(0, 0), cB, voffB); PG8_STAGE(PG8_SB(0, 1), cB + hstep, voffB); PG8_STAGE(PG8_SA(0, 0), cA, voffA); PG8_STAGE(PG8_SA(0, 1), cA + hstep, voffA);
        if (wr == 1) PG8_BAR;
        PG8_WAIT_V(2); PG8_BAR;
        PG8_STAGE(PG8_SB(1, 0), cB + kstep, voffB); PG8_STAGE(PG8_SA(1, 0), cA + kstep, voffA); PG8_STAGE(PG8_SB(1, 1), cB + hstep + kstep, voffB);
        PG8_WAIT_V(6); PG8_BAR;
    } else {
        PG8_STAGE(PG8_SB(0, 0), cB, voffB); PG8_STAGE(PG8_SA(0, 0), cA, voffA); PG8_STAGE(PG8_SB(0, 1), cB + hstep, voffB); PG8_STAGE(PG8_SA(0, 1), cA + hstep, voffA);
        if (wr == 1) PG8_BAR;
        PG8_WAIT_V(4); PG8_BAR;
        PG8_STAGE(PG8_SB(1, 0), cB + kstep, voffB); PG8_STAGE(PG8_SA(1, 0), cA + kstep, voffA); PG8_STAGE(PG8_SB(1, 1), cB + hstep + kstep, voffB);
        PG8_WAIT_V(6); PG8_BAR;
    }
    for (;;) {
        const bool has_next = S.next(ui + 1, nxt);
        const char* nA = has_next ? (const char*)g.A + (size_t)nxt.pm * tstep : cA; const char* nB = has_next ? (const char*)g.Bt + (size_t)nxt.pn * tstep : cB;
        for (int t = 0; t < nt; t += 2) {
            const bool last = (t == nt - 2);
            const char* a1 = cA + (size_t)(t + 1) * kstep;
            const char* a2 = last ? nA : cA + (size_t)(t + 2) * kstep; const char* b2 = last ? nB : cB + (size_t)(t + 2) * kstep;
            const char* a3 = a2 + kstep; const char* b3 = b2 + kstep;
            if (last && has_next) S.a_ready(nxt);
            if constexpr (SP2) {
            PG8_LDB(B0, 0, 0); PG8_LDB(B1, 0, 1); PG8_SCHED; PG8_LDA(At, 0, 0); PG8_STAGE(PG8_SA(1, 1), a1 + hstep, voffA);
            PG8_WAIT_V(8); PG8_WAIT_L(0); PG8_BAR; PG8_MMA(0, 0, At, B0); PG8_MMA(0, 1, At, B1); PG8_BAR; PG8_SCHED;
            PG8_LDA(At, 0, 1); PG8_STAGE(PG8_SB(0, 0), b2, voffB); PG8_STAGE(PG8_SB(0, 1), b2 + hstep, voffB); PG8_STAGE(PG8_SA(0, 0), a2, voffA);
            PG8_WAIT_V(8); PG8_WAIT_L(0); PG8_BAR; PG8_MMA(1, 0, At, B0); PG8_MMA(1, 1, At, B1); PG8_BAR; PG8_SCHED;
            PG8_LDB(B0, 1, 0); PG8_LDB(B1, 1, 1); PG8_SCHED; PG8_LDA(At, 1, 0); PG8_STAGE(PG8_SA(0, 1), a2 + hstep, voffA);
            PG8_WAIT_V(8); PG8_WAIT_L(0); PG8_BAR; PG8_MMA(0, 0, At, B0); PG8_MMA(0, 1, At, B1); PG8_BAR; PG8_SCHED;
            PG8_LDA(At, 1, 1); PG8_STAGE(PG8_SB(1, 0), b3, voffB); PG8_STAGE(PG8_SB(1, 1), b3 + hstep, voffB); PG8_STAGE(PG8_SA(1, 0), a3, voffA);
            PG8_WAIT_V(8); PG8_WAIT_L(0); PG8_BAR; PG8_MMA(1, 0, At, B0); PG8_MMA(1, 1, At, B1); PG8_BAR; PG8_SCHED;
            } else {
            PG8_LDB(B0, 0, 0); PG8_SCHED; PG8_LDA(At, 0, 0); PG8_STAGE(PG8_SA(1, 1), a1 + hstep, voffA);
            PG8_WAIT_L(8); PG8_BAR; PG8_WAIT_L(0); PG8_MMA(0, 0, At, B0); PG8_BAR; PG8_SCHED;
            PG8_LDB(B1, 0, 1); PG8_STAGE(PG8_SB(0, 0), b2, voffB);
            PG8_BAR; PG8_WAIT_L(0); PG8_MMA(0, 1, At, B1); PG8_BAR;
            PG8_LDA(At, 0, 1); PG8_STAGE(PG8_SA(0, 0), a2, voffA);
            PG8_BAR; PG8_WAIT_L(0); PG8_MMA(1, 0, At, B0); PG8_BAR; PG8_SCHED;
            PG8_STAGE(PG8_SB(0, 1), b2 + hstep, voffB);
            PG8_WAIT_V(6); PG8_BAR; PG8_MMA(1, 1, At, B1); PG8_BAR;
            PG8_LDB(B0, 1, 0); PG8_SCHED; PG8_LDA(At, 1, 0); PG8_STAGE(PG8_SA(0, 1), a2 + hstep, voffA);
            PG8_WAIT_L(8); PG8_BAR; PG8_WAIT_L(0); PG8_MMA(0, 0, At, B0); PG8_BAR; PG8_SCHED;
            PG8_LDB(B1, 1, 1); PG8_STAGE(PG8_SB(1, 0), b3, voffB);
            PG8_BAR; PG8_WAIT_L(0); PG8_MMA(0, 1, At, B1); PG8_BAR;
            PG8_LDA(At, 1, 1); PG8_STAGE(PG8_SA(1, 0), a3, voffA);
            PG8_BAR; PG8_WAIT_L(0); PG8_MMA(1, 0, At, B0); PG8_BAR; PG8_SCHED;
            PG8_STAGE(PG8_SB(1, 1), b3 + hstep, voffB);
            PG8_WAIT_V(6); PG8_BAR; PG8_MMA(1, 1, At, B1); PG8_BAR;
            }
        }
        if constexpr (ALIGN_EPI) { if (wr == 0) PG8_BAR; }
        if constexpr (!Epi::AFTER_DRAIN) { E(acc, cur, wr, wc, fr, fq); S.done(cur); }
        if (!has_next) break;
#pragma unroll
        for (int a = 0; a < 2; ++a)
#pragma unroll
            for (int b = 0; b < 2; ++b)
#pragma unroll
                for (int m = 0; m < 4; ++m)
#pragma unroll
                    for (int n = 0; n < 2; ++n) acc[a][b][m][n] = (f32x4){0.f, 0.f, 0.f, 0.f};
        cur = nxt; cA = nA; cB = nB; ++ui;
        if constexpr (ALIGN_EPI) { if (wr == 1) PG8_BAR; }
    }
    PG8_WAIT_V(0);
    if constexpr (!ALIGN_EPI) { if (wr == 0) PG8_BAR; }
    PG8_BAR;
    if constexpr (Epi::AFTER_DRAIN) { E.fused(acc, cur, wr, wc, fr, fq, lds, wid, lane); S.done(cur); }
#undef PG8_SA
#undef PG8_SB
#undef PG8_STAGE
#undef PG8_LDA
#undef PG8_LDB
#undef PG8_MMA
#undef PG8_WAIT_V
#undef PG8_WAIT_L
#undef PG8_BAR
#undef PG8_SCHED
}
}

#define LAS __attribute__((address_space(3)))
typedef unsigned short bf16_t;
typedef unsigned u32x4 __attribute__((ext_vector_type(4)));
typedef unsigned u32x2 __attribute__((ext_vector_type(2)));
typedef float f32x4 __attribute__((ext_vector_type(4)));
typedef float f32x2 __attribute__((ext_vector_type(2)));
typedef short bf16x8 __attribute__((ext_vector_type(8)));
typedef short bf16x4 __attribute__((ext_vector_type(4)));
#define LDS_WAIT() asm volatile("s_waitcnt lgkmcnt(0)" ::: "memory")
__device__ __forceinline__ unsigned f2bf(float f) { unsigned u = __builtin_bit_cast(unsigned, f); return (u + 0x7fffu + ((u >> 16) & 1u)) >> 16; }
__device__ __forceinline__ unsigned pk2(float lo, float hi) { unsigned r; asm("v_cvt_pk_bf16_f32 %0, %1, %2" : "=v"(r) : "v"(lo), "v"(hi)); return r; }
__device__ __forceinline__ float bf2f(unsigned short h) { return __builtin_bit_cast(float, (unsigned)h << 16); }
__device__ __forceinline__ float dppf(float v, const int ctrl) { return v; }
#define DPP_ADD(v, ctrl) ((v) + __builtin_bit_cast(float, __builtin_amdgcn_mov_dpp(__builtin_bit_cast(int, (v)), (ctrl), 0xF, 0xF, true)))
__device__ __forceinline__ float row16_sum(float v) {
    v = DPP_ADD(v, 0xB1);
    v = DPP_ADD(v, 0x4E);
    v = DPP_ADD(v, 0x141);
    v = DPP_ADD(v, 0x140);
    return v;
}
__device__ __forceinline__ float wave_sum(float v) {
    const int iv = __builtin_bit_cast(int, row16_sum(v));
    const float a = __builtin_bit_cast(float, __builtin_amdgcn_readlane(iv, 0)), b = __builtin_bit_cast(float, __builtin_amdgcn_readlane(iv, 16));
    const float c = __builtin_bit_cast(float, __builtin_amdgcn_readlane(iv, 32)), d = __builtin_bit_cast(float, __builtin_amdgcn_readlane(iv, 48));
    return (a + b) + (c + d);
}
__device__ __forceinline__ float sigmoidf_(float x) { return __builtin_amdgcn_rcpf(1.0f + __builtin_amdgcn_exp2f(-1.4426950408889634f * x)); }
__device__ __forceinline__ float tanhf_(float x) { return 1.0f - 2.0f * __builtin_amdgcn_rcpf(1.0f + __builtin_amdgcn_exp2f(2.8853900817779268f * x)); }

#define XB_TMO      128
#define XB_XCNT(j)  (256  + 64 * (j))
#define XB_XSUB(j)  (1280 + 64 * (j))
#define XB_XGEN(j)  (2304 + 64 * (j))
#define XB_TOP      3328
#define XB_TOPGEN   3392
#define XCD_BAR_WORDS 3456
#define XB_SPIN_CAP (1u << 18)

__device__ __forceinline__ unsigned xb_ld(unsigned* p)              { return __hip_atomic_load(p, __ATOMIC_RELAXED, __HIP_MEMORY_SCOPE_AGENT); }
__device__ __forceinline__ unsigned xb_add(unsigned* p, unsigned v) { return __hip_atomic_fetch_add(p, v, __ATOMIC_RELAXED, __HIP_MEMORY_SCOPE_AGENT); }
__device__ __forceinline__ unsigned xb_xcc_id() { return (unsigned)__builtin_amdgcn_s_getreg((3 << 11) | 20) & 0xFu; }
#define XB_SPIN(cond, bar) do { unsigned _sp = 0; while (cond) { __builtin_amdgcn_s_sleep(1); \
    if ((++_sp & 255u) == 0u) { if (xb_ld(&(bar)[XB_TMO])) break; if (_sp > XB_SPIN_CAP) { atomicAdd(&(bar)[XB_TMO], 1u); break; } } } } while (0)

struct XcdBarrier {
    unsigned* bar; unsigned x;
    volatile LAS unsigned* st;
};

__device__ __forceinline__ XcdBarrier xcd_barrier_post(unsigned* bar, volatile LAS unsigned* st) {
    XcdBarrier b; b.bar = bar; b.x = xb_xcc_id(); b.st = st;
    if (threadIdx.x == 0) (void)xb_add(&bar[XB_XCNT(b.x)], 1u);
    return b;
}
__device__ __forceinline__ void xcd_barrier_complete(unsigned* bar, unsigned x, unsigned& nloc, unsigned& nx) {
    const unsigned G = gridDim.x * gridDim.y * gridDim.z;
    unsigned sum, cnt, mine, sp = 0u;
    for (;;) {
        sum = 0u; cnt = 0u; mine = 0u;
#pragma unroll
        for (unsigned j = 0; j < 16; ++j) { const unsigned c = xb_ld(&bar[XB_XCNT(j)]); sum += c; cnt += (c > 0u) ? 1u : 0u; mine = (j == x) ? c : mine; }
        if (sum == G) break;
        __builtin_amdgcn_s_sleep(1);
        if ((++sp & 255u) == 0u) { if (xb_ld(&bar[XB_TMO])) break; if (sp > XB_SPIN_CAP) { atomicAdd(&bar[XB_TMO], 1u); break; } }
    }
    nloc = mine > 0u ? mine : 1u; nx = cnt > 0u ? cnt : 1u;
}

__device__ __forceinline__ void xcd_barrier(const XcdBarrier& b, const bool is_t0) {
    asm volatile("s_waitcnt vmcnt(0)" ::: "memory");
    __syncthreads();
    if (is_t0) {
        unsigned long long bi_ = (unsigned long long)b.bar; asm volatile("" : "+v"(bi_)); unsigned* bar = (unsigned*)(__attribute__((address_space(1))) unsigned*)bi_;
        __builtin_amdgcn_s_waitcnt(0);
        unsigned nloc = b.st[0], nx = b.st[1];
        if (nloc == 0u) { xcd_barrier_complete(bar, b.x, nloc, nx); b.st[0] = nloc; b.st[1] = nx; }
        const unsigned old = xb_add(&bar[XB_XSUB(b.x)], 1u);
        const unsigned gen = old / nloc;
        if (old + 1u == (gen + 1u) * nloc) {
            __builtin_amdgcn_fence(__ATOMIC_RELEASE, "agent");
            asm volatile("s_waitcnt vmcnt(0)" ::: "memory");
            const unsigned og = xb_add(&bar[XB_TOP], 1u);
            const unsigned tg = og / nx;
            if (og + 1u == (tg + 1u) * nx) xb_add(&bar[XB_TOPGEN], 1u);
            else XB_SPIN(xb_ld(&bar[XB_TOPGEN]) == tg, bar);
            __builtin_amdgcn_fence(__ATOMIC_ACQUIRE, "agent");
            xb_add(&bar[XB_XGEN(b.x)], 1u);
            asm volatile("s_waitcnt vmcnt(0)" ::: "memory");
        } else {
            XB_SPIN(xb_ld(&bar[XB_XGEN(b.x)]) == gen, bar);
            __builtin_amdgcn_fence(__ATOMIC_ACQUIRE, "agent");
            asm volatile("s_waitcnt vmcnt(0)" ::: "memory");
        }
    }
    __syncthreads();
}

constexpr size_t MiB = 1u << 20;
constexpr size_t al1(size_t x) { return (x + MiB - 1) / MiB * MiB; }
constexpr size_t WS_CTL = 0, CTL_ZERO_BYTES = 2 * MiB;
constexpr int CW_BAR = 4096, CW_FIN = 16384;
constexpr size_t SSQ_OFF = 256 * 1024;
constexpr size_t WS_ROPE = WS_CTL + CTL_ZERO_BYTES;
constexpr size_t WS_WLT = WS_ROPE + al1(2056 * 16 * 4);
constexpr size_t WS_X = WS_WLT + al1((size_t)DEPTH * 3 * 512 * 96 * 2);
constexpr size_t WS_XN = WS_X + al1((size_t)MTOT * DM * 4);
constexpr size_t WS_QA = WS_XN + al1((size_t)MTOT * DM * 2);
constexpr size_t WS_KA = WS_QA + al1((size_t)MTOT * 512 * 2);
constexpr size_t WS_VA = WS_KA + al1((size_t)MTOT * 512 * 2);
constexpr size_t WS_PB = WS_VA + al1((size_t)MTOT * 512 * 2);
constexpr size_t WS_QC = WS_PB + al1((size_t)MTOT * BCOLS * 4);
constexpr size_t WS_KC = WS_QC + al1((size_t)MTOT * 1024 * 2);
constexpr size_t WS_VC = WS_KC + al1((size_t)MTOT * 128 * 2);
constexpr size_t WS_MIX = WS_VC + al1((size_t)MTOT * 128 * 2);
constexpr size_t WS_ACT = WS_MIX + al1((size_t)MTOT * DM * 2);
constexpr size_t WS_OA = WS_ACT + al1((size_t)MTOT * FF * 2);
constexpr size_t WS_LSE = WS_OA + al1((size_t)3 * MP * 512 * 4);
constexpr int NTH = MP * 8 + MS * 8;
constexpr size_t WS_OPS = WS_LSE + al1((size_t)3 * MP * 8 * 4);
constexpr size_t WS_GG = WS_OPS + al1((size_t)NTH * 6 * 64 * 4);
constexpr size_t WS_BON = WS_GG + al1((size_t)NTH * 64 * 4);
constexpr size_t WS_YZ = WS_BON + al1((size_t)NTH * 4);
constexpr size_t WS_YS = WS_YZ + al1((size_t)MP * 8 * 128 * 4);
constexpr size_t WS_ENDS = WS_YS + al1((size_t)MS * 8 * 64 * 4);
constexpr size_t WS_PART = WS_ENDS + al1((size_t)256 * 2 * 4096 * 4);
constexpr size_t WS_WIN = WS_PART + al1((size_t)22 * MS * DM * 4);
constexpr size_t WS_WOUT = WS_WIN + al1((size_t)DEPTH * INC * DM * 2);
constexpr size_t WS_WGU = WS_WOUT + al1((size_t)DEPTH * DM * DM * 2);
constexpr size_t WS_WDN = WS_WGU + al1((size_t)DEPTH * NGU * DM * 2);
constexpr size_t WS_END = WS_WDN + al1((size_t)DEPTH * DM * FF * 2);

constexpr size_t O_YP = 0, O_YS = O_YP + (size_t)MP * DM, O_AKP = O_YS + (size_t)MS * DM, O_AVP = O_AKP + (size_t)DEPTH * MP * 512, O_CKP = O_AVP + (size_t)DEPTH * MP * 512,
    O_CVP = O_CKP + (size_t)DEPTH * NBATCH * 128 * 128, O_WKVP = O_CVP + (size_t)DEPTH * NBATCH * 128 * 128, O_SHP = O_WKVP + (size_t)DEPTH * NBATCH * 8 * 4096,
    O_AKS = O_SHP + (size_t)DEPTH * NBATCH * BCOLS, O_AVS = O_AKS + (size_t)DEPTH * MS * 512, O_CKS = O_AVS + (size_t)DEPTH * MS * 512, O_CVS = O_CKS + (size_t)DEPTH * MS * 128,
    O_WKVS = O_CVS + (size_t)DEPTH * MS * 128, O_SHS = O_WKVS + (size_t)DEPTH * DECB * 8 * 4096, O_END = O_SHS + (size_t)DEPTH * DECB * BCOLS;

constexpr int RING_BYTES = 139264, MISC_OFF = RING_BYTES + 320, LDS_BYTES = 147456;

constexpr int P0_TS = 136;
__device__ __forceinline__ void p0_item(const float* W, int K, int N, bf16_t* WT, const float* gk, int mode, LAS unsigned char* scr, int item, int lane) {
    const int nblk = N / 64, kb = item / nblk, nb = item % nblk, k0 = 64 * kb, n0 = 64 * nb;
    const int nq = lane & 15, kq = lane >> 4;
    const float* wp = W + (size_t)(k0 + 16 * kq) * N + n0 + 4 * nq;
    f32x4 v[16];
#pragma unroll
    for (int i = 0; i < 16; ++i) v[i] = *(const f32x4*)(wp + (size_t)i * N);
    if (gk) {
        const f32x4 g0 = *(const f32x4*)(gk + k0 + 16 * kq), g1 = *(const f32x4*)(gk + k0 + 16 * kq + 4), g2 = *(const f32x4*)(gk + k0 + 16 * kq + 8), g3 = *(const f32x4*)(gk + k0 + 16 * kq + 12);
#pragma unroll
        for (int i = 0; i < 4; ++i) { v[i] = v[i] * g0[i]; v[4 + i] = v[4 + i] * g1[i]; v[8 + i] = v[8 + i] * g2[i]; v[12 + i] = v[12 + i] * g3[i]; }
    }
#pragma unroll
    for (int j = 0; j < 4; ++j) {
        u32x4 a, b;
        a.x = pk2(v[0][j], v[1][j]); a.y = pk2(v[2][j], v[3][j]); a.z = pk2(v[4][j], v[5][j]); a.w = pk2(v[6][j], v[7][j]);
        b.x = pk2(v[8][j], v[9][j]); b.y = pk2(v[10][j], v[11][j]); b.z = pk2(v[12][j], v[13][j]); b.w = pk2(v[14][j], v[15][j]);
        LAS unsigned char* t = scr + (4 * nq + j) * P0_TS + 32 * kq;
        *(LAS u32x4*)t = a; *(LAS u32x4*)(t + 16) = b;
    }
    LDS_WAIT(); asm volatile("" ::: "memory");
    const int c = lane & 7;
#pragma unroll
    for (int it = 0; it < 8; ++it) {
        const int n = (lane >> 3) + 8 * it;
        const u32x4 o = *(const LAS u32x4*)(scr + n * P0_TS + 16 * c);
        const int nn = n0 + n; const int orow = mode == 0 ? nn : (256 * (nn >> 7) + (nn & 127) + (mode == 2 ? 128 : 0));
        *(u32x4*)(WT + (size_t)orow * K + k0 + 8 * c) = o;
    }
    LDS_WAIT(); asm volatile("" ::: "memory");
}

constexpr int IT_IN = (DM / 64) * (INC / 64), IT_OUT = (DM / 64) * (DM / 64), IT_G = (DM / 64) * (FF / 64), IT_D = (FF / 64) * (DM / 64), IT_A = IT_IN + IT_OUT + IT_D, IT_B = 2 * IT_G;
#define CONV_ITEM_A(ly, r_) do { int r = (r_); \
    if (r < IT_IN) { p0_item(IN(I_WIN) + (size_t)(ly) * DM * INC, DM, INC, G_WIN + (size_t)(ly) * INC * DM, IN(I_GMIX) + (ly) * DM, 0, scr, r, lane); break; } r -= IT_IN; \
    if (r < IT_OUT) { p0_item(IN(I_WOUT) + (size_t)(ly) * DM * DM, DM, DM, G_WOUT + (size_t)(ly) * DM * DM, nullptr, 0, scr, r, lane); break; } r -= IT_OUT; \
    p0_item(IN(I_WD) + (size_t)(ly) * FF * DM, FF, DM, G_WDN + (size_t)(ly) * DM * FF, nullptr, 0, scr, r, lane); } while (0)
#define CONV_ITEM_B(ly, r_) do { int r = (r_); \
    if (r < IT_G) { p0_item(IN(I_WG) + (size_t)(ly) * DM * FF, DM, FF, G_WGU + (size_t)(ly) * NGU * DM, IN(I_GFFN) + (ly) * DM, 1, scr, r, lane); break; } r -= IT_G; \
    p0_item(IN(I_WU) + (size_t)(ly) * DM * FF, DM, FF, G_WGU + (size_t)(ly) * NGU * DM, IN(I_GFFN) + (ly) * DM, 2, scr, r, lane); } while (0)

constexpr int KS_STRIDE = 144, KS_BYTES = 256 * KS_STRIDE, VT_OFF = KS_BYTES;
typedef short v4i16_t __attribute__((ext_vector_type(4)));
__device__ __forceinline__ u32x2 vtr(const LAS unsigned char* p) { return __builtin_bit_cast(u32x2, __builtin_amdgcn_ds_read_tr16_b64_v4i16((LAS v4i16_t*)p)); }
__device__ __forceinline__ void band_load_kv(u32x4 (&kr)[4], u32x4 (&vr)[4], const bf16_t* K, const bf16_t* V, int ldkv, int kvcol, int rowbase, int dil, int res, int s0, bool has_prev, int tid) {
#pragma unroll
    for (int it = 0; it < 4; ++it) {
        const int idx = tid + 512 * it, key = idx >> 3, ch = idx & 7;
        const int s = s0 - 128 + key; const bool ok = has_prev || key >= 128;
        const size_t roff = (size_t)(rowbase + dil * (ok ? s : s0) + res) * ldkv + kvcol + ch * 8;
        kr[it] = *(const u32x4*)(K + roff); vr[it] = *(const u32x4*)(V + roff);
        if (!ok) { kr[it] = (u32x4){0u, 0u, 0u, 0u}; vr[it] = kr[it]; }
    }
}
__device__ __forceinline__ void band_store_kv(LAS unsigned char* lds, const u32x4 (&kr)[4], const u32x4 (&vr)[4], int tid) {
#pragma unroll
    for (int it = 0; it < 4; ++it) {
        const int idx = tid + 512 * it, key = idx >> 3, ch = idx & 7;
        *(LAS u32x4*)(lds + key * KS_STRIDE + ch * 16) = kr[it];
        *(LAS u32x4*)(lds + VT_OFF + key * KS_STRIDE + ch * 16) = vr[it];
    }
}
__device__ __forceinline__ void band_head(LAS unsigned char* lds, const bf16x8 q0, const bf16x8 q1  , bool has_prev, int w, int lane, f32x4 (&o)[4], float& mrow, float& lrow) {
    const int fr = lane & 15, fq = lane >> 4;
    f32x4 st[10];
#pragma unroll
    for (int T = 0; T < 9; ++T) {
        const LAS unsigned char* kp = lds + (16 * (w + T) + fr) * KS_STRIDE + fq * 16;
        const bf16x8 k0 = *(const LAS bf16x8*)kp, k1 = *(const LAS bf16x8*)(kp + 64);
        f32x4 a = (f32x4){0.f, 0.f, 0.f, 0.f};
        a = __builtin_amdgcn_mfma_f32_16x16x32_bf16(k0, q0, a, 0, 0, 0);
        a = __builtin_amdgcn_mfma_f32_16x16x32_bf16(k1, q1, a, 0, 0, 0);
        st[T] = a;
        if (T & 1) __builtin_amdgcn_sched_barrier(0);
    }
    float mx = -INFINITY;
#pragma unroll
    for (int T = 0; T < 9; ++T)
#pragma unroll
        for (int r = 0; r < 4; ++r) {
            const int dlt = 16 * T + 4 * fq + r - fr;
            const int j = 16 * (w + T) + 4 * fq + r;
            const bool ok = dlt >= 0 && dlt <= 128 && (has_prev || j >= 128);
            const float s = ok ? st[T][r] : -INFINITY; st[T][r] = s; mx = fmaxf(mx, s);
        }
    mx = fmaxf(mx, __shfl_xor(mx, 16)); mx = fmaxf(mx, __shfl_xor(mx, 32));
    float ls = 0.f;
#pragma unroll
    for (int T = 0; T < 9; ++T)
#pragma unroll
        for (int r = 0; r < 4; ++r) { const float p = __builtin_amdgcn_exp2f(st[T][r] - mx); st[T][r] = p; ls += p; }
    st[9] = (f32x4){0.f, 0.f, 0.f, 0.f};
    ls += __shfl_xor(ls, 16); ls += __shfl_xor(ls, 32);
#pragma unroll
    for (int dt = 0; dt < 4; ++dt) o[dt] = (f32x4){0.f, 0.f, 0.f, 0.f};
#pragma unroll
    for (int pp = 0; pp < 5; ++pp) {
        u32x4 pw; pw.x = pk2(st[2 * pp][0], st[2 * pp][1]); pw.y = pk2(st[2 * pp][2], st[2 * pp][3]); pw.z = pk2(st[2 * pp + 1][0], st[2 * pp + 1][1]); pw.w = pk2(st[2 * pp + 1][2], st[2 * pp + 1][3]);
        const bf16x8 pf = __builtin_bit_cast(bf16x8, pw);
        const int kt0 = w + 2 * pp, kt1 = (kt0 + 1 > 15) ? 15 : kt0 + 1;
#pragma unroll
        for (int dt = 0; dt < 4; ++dt) {
            const LAS unsigned char* vp = lds + VT_OFF + (4 * fq + ((lane >> 2) & 3)) * KS_STRIDE + (lane & 3) * 8 + dt * 32;
            const u32x2 va = vtr(vp + kt0 * 16 * KS_STRIDE), vb = vtr(vp + kt1 * 16 * KS_STRIDE);
            u32x4 vw; vw.x = va.x; vw.y = va.y; vw.z = vb.x; vw.w = vb.y;
            o[dt] = __builtin_amdgcn_mfma_f32_16x16x32_bf16(__builtin_bit_cast(bf16x8, vw), pf, o[dt], 0, 0, 0);
        }
        __builtin_amdgcn_sched_barrier(0);
    }
    mrow = mx; lrow = ls;
}

template <int NBR>
__device__ __forceinline__ void dec_attn(const bf16_t* q, const float* Kc, const float* Vc, const float* Kn, const float* Vn, int rs, int nbuf, int t, int lane, f32x4& oout, float& lse) {
    const int sub = lane >> 4, c = lane & 15;
    const u32x2 qw = *(const u32x2*)(q + 4 * c);
    const f32x4 q4 = (f32x4){bf2f((unsigned short)(qw.x & 0xffffu)), bf2f((unsigned short)(qw.x >> 16)), bf2f((unsigned short)(qw.y & 0xffffu)), bf2f((unsigned short)(qw.y >> 16))};
    float m = -INFINITY, l = 0.f; f32x4 acc = (f32x4){0.f, 0.f, 0.f, 0.f};
#pragma unroll 1
    for (int bb = 0; bb < NBR * 3; ++bb) {
        const int br = bb / 3, jb = bb - 3 * br; const int dil = br == 0 ? 1 : (br == 1 ? 4 : 16);
        f32x4 k4[11], v4[11]; float s[11]; float bm = -INFINITY;
#pragma unroll
        for (int u = 0; u < 11; ++u) {
            const int jt = 11 * jb + u; const int j = 4 * jt + sub; const bool ok = jt < 32 || sub == 0;
            const int idx = nbuf + t - dil * (ok ? j : 0);
            const float* kp = idx < nbuf ? Kc + (size_t)idx * rs : Kn + (size_t)(idx - nbuf) * rs;
            const float* vp = idx < nbuf ? Vc + (size_t)idx * rs : Vn + (size_t)(idx - nbuf) * rs;
            k4[u] = *(const f32x4*)(kp + 4 * c); v4[u] = *(const f32x4*)(vp + 4 * c);
        }
#pragma unroll
        for (int u = 0; u < 11; ++u) {
            const int jt = 11 * jb + u; const bool ok = jt < 32 || sub == 0;
            float x = (q4[0] * k4[u][0] + q4[1] * k4[u][1]) + (q4[2] * k4[u][2] + q4[3] * k4[u][3]);
            x = row16_sum(x); if (!ok) x = -INFINITY;
            s[u] = x; bm = fmaxf(bm, x);
        }
        const float mn = fmaxf(m, bm), corr = __builtin_amdgcn_exp2f(m - mn);
        l *= corr; acc = acc * corr; m = mn;
#pragma unroll
        for (int u = 0; u < 11; ++u) { const float p = __builtin_amdgcn_exp2f(s[u] - mn); l += p; acc = acc + v4[u] * p; }
    }
#pragma unroll
    for (int o = 16; o <= 32; o <<= 1) {
        const float mo = __shfl_xor(m, o), lo = __shfl_xor(l, o);
        f32x4 ao; ao[0] = __shfl_xor(acc[0], o); ao[1] = __shfl_xor(acc[1], o); ao[2] = __shfl_xor(acc[2], o); ao[3] = __shfl_xor(acc[3], o);
        const float mn = fmaxf(m, mo), c0 = __builtin_amdgcn_exp2f(m - mn), c1 = __builtin_amdgcn_exp2f(mo - mn);
        l = l * c0 + lo * c1; acc = acc * c0 + ao * c1; m = mn;
    }
    oout = acc * (1.0f / l); lse = (m + __builtin_amdgcn_logf(l)) * LN2F;
}

constexpr int XL_STRIDE = 528;
constexpr int PRE_WOFF = 68096, PRE_WS = 208;
__device__ __forceinline__ void rwkv_stage_weights(LAS unsigned char* lds, const bf16_t* wlt, int h, int tid) {
    for (int idx = tid; idx < 3 * 64 * 12; idx += 512) {
        const int mat = idx / 768, rem = idx - 768 * mat, row = rem / 12, chn = rem - 12 * row;
        *(LAS u32x4*)(lds + PRE_WOFF + (mat * 64 + row) * PRE_WS + chn * 16) = *(const u32x4*)(wlt + (size_t)mat * 512 * 96 + (size_t)(h * 64 + row) * 96 + chn * 8);
    }
}
struct RwkvW { const float *mu, *w0, *a0, *kk, *ka, *rk; const bf16_t* wlt; };
__device__ __forceinline__ void rwkv_prepass_tile(LAS unsigned char* lds, const float* PB, int prow0, const float* prev0, int ntok, int h, const RwkvW& W, float* OPS, float* GG, float* BON, int th0, int tid_in, int w) {
    int tid = tid_in; asm volatile("" : "+v"(tid));
    const int lane = tid & 63;
    {
        const int k = (tid & 63) * 4;
        const f32x4 mu4 = *(const f32x4*)(W.mu + 1536 + k);
        const f32x4 z4 = (f32x4){0.f, 0.f, 0.f, 0.f};
#define PRE_LOAD(i0_, cd, pd) do { _Pragma("unroll") for (int u = 0; u < 8; ++u) { \
            const int i = (i0_) + 8 * u; const int ii = i < ntok ? i : 0; \
            cd[u] = *(const f32x4*)(PB + (size_t)(prow0 + ii) * BCOLS + 1536 + k); \
            const float* pp = ii > 0 ? PB + (size_t)(prow0 + ii - 1) * BCOLS : prev0; \
            pd[u] = pp ? *(const f32x4*)(pp + 1536 + k) : z4; } } while (0)
        f32x4 cur[8], prv[8], curn[8], prvn[8];
        PRE_LOAD(w, cur, prv);
#pragma unroll 1
        for (int i0 = w; i0 < ntok; i0 += 64) {
            if (i0 + 64 < ntok) PRE_LOAD(i0 + 64, curn, prvn);
#pragma unroll
            for (int u = 0; u < 8; ++u) {
                const int i = i0 + 8 * u;
                f32x4 x = cur[u] + (prv[u] - cur[u]) * mu4;
                if (k < 96) { x[0] = tanhf_(x[0]); x[1] = tanhf_(x[1]); x[2] = tanhf_(x[2]); x[3] = tanhf_(x[3]); }
                else if (k >= 192) { x[0] = sigmoidf_(x[0]); x[1] = sigmoidf_(x[1]); x[2] = sigmoidf_(x[2]); x[3] = sigmoidf_(x[3]); }
                u32x2 o; o.x = pk2(x[0], x[1]); o.y = pk2(x[2], x[3]);
                if (i < ntok) *(LAS u32x2*)(lds + i * XL_STRIDE + k * 2) = o;
            }
#pragma unroll
            for (int u = 0; u < 8; ++u) { cur[u] = curn[u]; prv[u] = prvn[u]; }
        }
#undef PRE_LOAD
    }
    __syncthreads();
#pragma unroll 1
    for (int mt = w; 16 * mt < ntok; mt += 8) {
        int lane2 = lane; asm volatile("" : "+v"(lane2));
        const int fr = lane2 & 15, fq = lane2 >> 4;
        const int i = 16 * mt + fr; const bool tok_ok = i < ntok; const int ic = tok_ok ? i : 0;
        f32x4 aw[4], aa[4], ag[4];
#pragma unroll
        for (int nt = 0; nt < 4; ++nt) { aw[nt] = (f32x4){0.f, 0.f, 0.f, 0.f}; aa[nt] = aw[nt]; ag[nt] = aw[nt]; }
        const LAS unsigned char* xrow = lds + (16 * mt + fr) * XL_STRIDE + fq * 16;
#pragma unroll
        for (int ks = 0; ks < 3; ++ks) {
            const bf16x8 xw = *(const LAS bf16x8*)(xrow + ks * 64), xa = *(const LAS bf16x8*)(xrow + 192 + ks * 64);
            bf16x8 xg = xw; if (ks < 2) xg = *(const LAS bf16x8*)(xrow + 384 + ks * 64);
#pragma unroll
            for (int nt = 0; nt < 4; ++nt) {
                const LAS unsigned char* wp = lds + PRE_WOFF + (16 * nt + fr) * PRE_WS + ks * 64 + fq * 16;
                aw[nt] = __builtin_amdgcn_mfma_f32_16x16x32_bf16(*(const LAS bf16x8*)wp, xw, aw[nt], 0, 0, 0);
                aa[nt] = __builtin_amdgcn_mfma_f32_16x16x32_bf16(*(const LAS bf16x8*)(wp + 64 * PRE_WS), xa, aa[nt], 0, 0, 0);
                if (ks < 2) ag[nt] = __builtin_amdgcn_mfma_f32_16x16x32_bf16(*(const LAS bf16x8*)(wp + 128 * PRE_WS), xg, ag[nt], 0, 0, 0);
            }
            __builtin_amdgcn_sched_barrier(0);
        }
        const float* cur = PB + (size_t)(prow0 + ic) * BCOLS;
        const float* prv = ic > 0 ? PB + (size_t)(prow0 + ic - 1) * BCOLS : prev0;
        const f32x4 z4 = (f32x4){0.f, 0.f, 0.f, 0.f};
        f32x4 cr[4], ck[4], cv[4], pr[4], pk[4], pv[4];
#pragma unroll
        for (int nt = 0; nt < 4; ++nt) {
            const int ch = h * 64 + 16 * nt + 4 * fq;
            cr[nt] = *(const f32x4*)(cur + ch); ck[nt] = *(const f32x4*)(cur + 512 + ch); cv[nt] = *(const f32x4*)(cur + 1024 + ch);
            pr[nt] = prv ? *(const f32x4*)(prv + ch) : z4; pk[nt] = prv ? *(const f32x4*)(prv + 512 + ch) : z4; pv[nt] = prv ? *(const f32x4*)(prv + 1024 + ch) : z4;
        }
        float nrm = 0.f;
#pragma unroll
        for (int nt = 0; nt < 4; ++nt) {
            const int ch = h * 64 + 16 * nt + 4 * fq;
            const f32x4 mk = *(const f32x4*)(W.mu + 512 + ch), kk = *(const f32x4*)(W.kk + ch);
            ck[nt] = ck[nt] + (pk[nt] - ck[nt]) * mk;
            const f32x4 kp = ck[nt] * kk;
            nrm += (kp[0] * kp[0] + kp[1] * kp[1]) + (kp[2] * kp[2] + kp[3] * kp[3]);
        }
        nrm += __shfl_xor(nrm, 16); nrm += __shfl_xor(nrm, 32);
        const float inv = 1.0f / fmaxf(sqrtf(nrm), 1e-12f);
        float bon = 0.f;
        float* op = OPS + (size_t)(th0 + ic) * 384; float* gp = GG + (size_t)(th0 + ic) * 64;
#pragma unroll
        for (int nt = 0; nt < 4; ++nt) {
            const int ch = h * 64 + 16 * nt + 4 * fq, cc = 16 * nt + 4 * fq;
            const f32x4 mr = *(const f32x4*)(W.mu + ch), mv = *(const f32x4*)(W.mu + 1024 + ch);
            const f32x4 rs = cr[nt] + (pr[nt] - cr[nt]) * mr, ksh = ck[nt], vs = cv[nt] + (pv[nt] - cv[nt]) * mv;
            const f32x4 w0 = *(const f32x4*)(W.w0 + ch), a0 = *(const f32x4*)(W.a0 + ch), kk = *(const f32x4*)(W.kk + ch), ka = *(const f32x4*)(W.ka + ch), rk = *(const f32x4*)(W.rk + ch);
            f32x4 dv, av, kmod;
#pragma unroll
            for (int r = 0; r < 4; ++r) {
                const float wp = w0[r] + aw[nt][r];
                const float sp = (-wp > 20.f) ? -wp : LN2F * __builtin_amdgcn_logf(1.0f + __builtin_amdgcn_exp2f(-1.4426950408889634f * wp));
                dv[r] = __builtin_amdgcn_exp2f(-1.4426950408889634f * __builtin_amdgcn_exp2f(1.4426950408889634f * (-sp - 0.5f)));
                const float a = sigmoidf_(a0[r] + aa[nt][r]); av[r] = a;
                kmod[r] = ksh[r] * (1.0f + (a - 1.0f) * ka[r]);
                bon += rs[r] * kmod[r] * rk[r];
            }
            const f32x4 kkn = ksh * kk * inv;
            if (tok_ok) {
                *(f32x4*)(op + 0 * 64 + cc) = kkn; *(f32x4*)(op + 1 * 64 + cc) = dv; *(f32x4*)(op + 2 * 64 + cc) = kkn * av;
                *(f32x4*)(op + 3 * 64 + cc) = kmod; *(f32x4*)(op + 4 * 64 + cc) = rs; *(f32x4*)(op + 5 * 64 + cc) = vs;
                *(f32x4*)(gp + cc) = ag[nt];
            }
        }
        bon += __shfl_xor(bon, 16); bon += __shfl_xor(bon, 32);
        if (tok_ok && fq == 0) BON[th0 + i] = bon;
    }
    __syncthreads();
}

__device__ __forceinline__ float row8_sum(float v) {
    v = DPP_ADD(v, 0xB1);
    v = DPP_ADD(v, 0x4E);
    v = DPP_ADD(v, 0x141);
    return v;
}
__device__ __forceinline__ float dot8(const f32x2 (&s)[4], const f32x2 (&o)[4]) { f32x2 a = s[0] * o[0]; a = s[1] * o[1] + a; a = s[2] * o[2] + a; a = s[3] * o[3] + a; return a.x + a.y; }
template <bool WITH_P>
__device__ __forceinline__ void rwkv_scan_t(LAS unsigned char* lds, const float* OPS, int th0, int nsteps, const float* init  , float* yz, int ystride, float* zend, float* pend, int tid, int w) {
    int lane = tid & 63; asm volatile("" : "+v"(lane));
    const int r = lane >> 3, jl = lane & 7, row = 8 * w + r;
    f32x2 Z[4], P[4];
#pragma unroll
    for (int q = 0; q < 4; ++q) {
        const int j = 8 * jl + 2 * q;
        P[q] = (f32x2){row == j ? 1.f : 0.f, row == j + 1 ? 1.f : 0.f};
        Z[q] = init ? *(const f32x2*)(init + row * 64 + j) : (f32x2){0.f, 0.f};
    }
    const f32x4* src = (const f32x4*)(OPS + (size_t)th0 * 384);
    const int nchunks = (nsteps + 31) >> 5;
    f32x4 pre[6];
#pragma unroll
    for (int k = 0; k < 6; ++k) { const int q = tid + 512 * k; pre[k] = (q < nsteps * 96) ? src[q] : (f32x4){0.f, 0.f, 0.f, 0.f}; }
#pragma unroll
    for (int k = 0; k < 6; ++k) *(LAS f32x4*)(lds + (size_t)(tid + 512 * k) * 16) = pre[k];
    for (int c = 0; c < nchunks; ++c) {
        __syncthreads();
        const bool more = c + 1 < nchunks;
        if (more) {
            int t2 = tid; asm volatile("" : "+v"(t2));
            const f32x4* s2 = (const f32x4*)(OPS + (size_t)th0 * 384) + (c + 1) * 3072 + t2;
#pragma unroll
            for (int k = 0; k < 6; ++k) { const int q = (c + 1) * 3072 + t2 + 512 * k; pre[k] = (q < nsteps * 96) ? s2[512 * k] : (f32x4){0.f, 0.f, 0.f, 0.f}; }
        }
        const LAS unsigned char* buf = lds + (c & 1) * 49152;
        const int nst = (nsteps - 32 * c) < 32 ? (nsteps - 32 * c) : 32;
#pragma unroll 1
        for (int t8 = 0; t8 < nst; t8 += 8) {
            float qz[8], qp[8];
#pragma unroll
            for (int u = 0; u < 8; ++u) {
                const LAS float* op = (const LAS float*)(buf + (t8 + u) * 1536) + 8 * jl;
                f32x2 kk[4], d[4], b[4], k[4], rr[4];
                { const f32x4 a0 = *(const LAS f32x4*)(op), a1 = *(const LAS f32x4*)(op + 4); kk[0] = (f32x2){a0[0], a0[1]}; kk[1] = (f32x2){a0[2], a0[3]}; kk[2] = (f32x2){a1[0], a1[1]}; kk[3] = (f32x2){a1[2], a1[3]}; }
                { const f32x4 a0 = *(const LAS f32x4*)(op + 64), a1 = *(const LAS f32x4*)(op + 68); d[0] = (f32x2){a0[0], a0[1]}; d[1] = (f32x2){a0[2], a0[3]}; d[2] = (f32x2){a1[0], a1[1]}; d[3] = (f32x2){a1[2], a1[3]}; }
                { const f32x4 a0 = *(const LAS f32x4*)(op + 128), a1 = *(const LAS f32x4*)(op + 132); b[0] = (f32x2){a0[0], a0[1]}; b[1] = (f32x2){a0[2], a0[3]}; b[2] = (f32x2){a1[0], a1[1]}; b[3] = (f32x2){a1[2], a1[3]}; }
                { const f32x4 a0 = *(const LAS f32x4*)(op + 192), a1 = *(const LAS f32x4*)(op + 196); k[0] = (f32x2){a0[0], a0[1]}; k[1] = (f32x2){a0[2], a0[3]}; k[2] = (f32x2){a1[0], a1[1]}; k[3] = (f32x2){a1[2], a1[3]}; }
                { const f32x4 a0 = *(const LAS f32x4*)(op + 256), a1 = *(const LAS f32x4*)(op + 260); rr[0] = (f32x2){a0[0], a0[1]}; rr[1] = (f32x2){a0[2], a0[3]}; rr[2] = (f32x2){a1[0], a1[1]}; rr[3] = (f32x2){a1[2], a1[3]}; }
                const float vv = *((const LAS float*)(buf + (t8 + u) * 1536) + 320 + row);
                const float saz = -row8_sum(dot8(Z, kk));
                float sap = 0.f; if (WITH_P) sap = -row8_sum(dot8(P, kk));
#pragma unroll
                for (int q = 0; q < 4; ++q) { Z[q] = Z[q] * d[q] + (b[q] * saz + k[q] * vv); if (WITH_P) P[q] = P[q] * d[q] + b[q] * sap; }
                qz[u] = dot8(Z, rr); if (WITH_P) qp[u] = dot8(P, rr);
            }
            float yzv = 0.f, ypv = 0.f;
#pragma unroll
            for (int u = 0; u < 8; ++u) { const float s = row8_sum(qz[u]); yzv = (jl == u) ? s : yzv; if (WITH_P) { const float s2 = row8_sum(qp[u]); ypv = (jl == u) ? s2 : ypv; } }
            int l3 = lane; asm volatile("" : "+v"(l3));
            float* yp = yz + (size_t)(32 * c + t8 + (l3 & 7)) * ystride + 8 * w + (l3 >> 3);
            if (t8 + (l3 & 7) < nst) { *yp = yzv; if (WITH_P) yp[64] = ypv; }
        }
        if (more) {
            LAS unsigned char* nb = lds + ((c + 1) & 1) * 49152;
#pragma unroll
            for (int k = 0; k < 6; ++k) *(LAS f32x4*)(nb + (size_t)(tid + 512 * k) * 16) = pre[k];
        }
    }
    {
        int l2 = lane; asm volatile("" : "+v"(l2));
        const int o = (8 * w + (l2 >> 3)) * 64 + 8 * (l2 & 7);
#pragma unroll
        for (int q = 0; q < 4; ++q) { *(f32x2*)(zend + o + 2 * q) = Z[q]; if (WITH_P) *(f32x2*)(pend + o + 2 * q) = P[q]; }
    }
    __syncthreads();
}
__device__ __forceinline__ void rwkv_scan(LAS unsigned char* lds, const float* OPS, int th0, int nsteps, const float* init, bool with_p, float* yz, int ystride, float* zend, float* pend, int tid, int w) {
    if (with_p) rwkv_scan_t<true>(lds, OPS, th0, nsteps, init, yz, ystride, zend, pend, tid, w);
    else rwkv_scan_t<false>(lds, OPS, th0, nsteps, init, yz, ystride, zend, pend, tid, w);
}

__device__ __forceinline__ void rwkv_out_token(float y, float lw, float lb, float bon, float v, float g, bf16_t* dst) {
    const float mean = wave_sum(y) * (1.0f / 64.0f); const float dlt = y - mean;
    const float var = wave_sum(dlt * dlt) * (1.0f / 64.0f);
    const float yn = dlt * rsqrtf(var + GN_EPS) * lw + lb;
    *dst = (bf16_t)f2bf((yn + bon * v) * g);
}

#ifndef REP_M1A
#define REP_M1A 1
#endif
#ifndef REP_M1B
#define REP_M1B 1
#endif
#ifndef REP_M1C
#define REP_M1C 1
#endif
#ifndef REP_M1D
#define REP_M1D 1
#endif
#ifndef REP_PIN
#define REP_PIN 1
#endif
#ifndef REP_M2
#define REP_M2 1
#endif
#ifndef REP_PGU
#define REP_PGU 1
#endif
#ifndef REP_POUT
#define REP_POUT 1
#endif
#ifndef REP_PDN
#define REP_PDN 1
#endif
struct Args { const float* in[28]; float* out; unsigned char* ws; };
enum { I_XP = 0, I_XS, I_CAK, I_CAV, I_CCK, I_CCV, I_WKV, I_SHIFT, I_GMIX, I_WIN, I_WOUT, I_MU, I_W0, I_W2, I_A0, I_A2, I_G2, I_KK, I_KA, I_RK, I_LNW, I_LNB, I_SINK, I_GFFN, I_WG, I_WU, I_WD, I_GFIN };

#define G_SSQ ((float*)(ws + WS_CTL + SSQ_OFF))
#define G_ROPE ((float*)(ws + WS_ROPE))
#define G_WLT ((bf16_t*)(ws + WS_WLT))
#define G_X ((float*)(ws + WS_X))
#define G_XN ((bf16_t*)(ws + WS_XN))
#define G_QA ((bf16_t*)(ws + WS_QA))
#define G_KA ((bf16_t*)(ws + WS_KA))
#define G_VA ((bf16_t*)(ws + WS_VA))
#define G_QC ((bf16_t*)(ws + WS_QC))
#define G_KC ((bf16_t*)(ws + WS_KC))
#define G_VC ((bf16_t*)(ws + WS_VC))
#define G_PB ((float*)(ws + WS_PB))
#define G_MIX ((bf16_t*)(ws + WS_MIX))
#define G_ACT ((bf16_t*)(ws + WS_ACT))
#define G_OA ((bf16_t*)(ws + WS_OA))
#define G_LSE ((float*)(ws + WS_LSE))
#define G_OPS ((float*)(ws + WS_OPS))
#define G_GG ((float*)(ws + WS_GG))
#define G_BON ((float*)(ws + WS_BON))
#define G_YZ ((float*)(ws + WS_YZ))
#define G_YS ((float*)(ws + WS_YS))
#define G_ENDS ((float*)(ws + WS_ENDS))
#define G_PART ((float*)(ws + WS_PART))
#define G_WIN ((bf16_t*)(ws + WS_WIN))
#define G_WOUT ((bf16_t*)(ws + WS_WOUT))
#define G_WGU ((bf16_t*)(ws + WS_WGU))
#define G_WDN ((bf16_t*)(ws + WS_WDN))
constexpr int PTAB_OFF = RING_BYTES + 1024;
template <class T> __device__ __forceinline__ T* ldptr(LAS unsigned char* lds, int i) {
    unsigned lo, hi; const unsigned addr = (unsigned)(uintptr_t)(lds + PTAB_OFF + 8 * i);
    asm volatile("v_mov_b32 %0, %2\n\tv_mov_b32 %1, %2\n\tds_read_b32 %0, %0\n\tds_read_b32 %1, %1 offset:4\n\ts_waitcnt lgkmcnt(0)" : "=&v"(lo), "=&v"(hi) : "s"(addr) : "memory");
    lo = __builtin_amdgcn_readfirstlane(lo); hi = __builtin_amdgcn_readfirstlane(hi);
    typedef __attribute__((address_space(1))) T GT;
    return (T*)(GT*)(((unsigned long long)hi << 32) | lo);
}
#define IN(i) ldptr<const float>(lds, (i))
#define GRID_BAR() do { XcdBarrier b_; b_.bar = (unsigned*)(ldptr<unsigned char>(lds, 29) + WS_CTL) + CW_BAR; b_.x = xb_xcc_id(); b_.st = (volatile LAS unsigned*)(lds + MISC_OFF) + 8; \
    int ln_; asm volatile("v_mbcnt_lo_u32_b32 %0, -1, 0\n\tv_mbcnt_hi_u32_b32 %0, -1, %0" : "=v"(ln_)); xcd_barrier(b_, wave0 == 0 && ln_ == 0); } while (0)
#define PHASE_BEGIN \
    int wave = wave0; asm volatile("" : "+s"(wave)); int vcu = vcu0; asm volatile("" : "+s"(vcu)); \
    int lane; asm volatile("v_mbcnt_lo_u32_b32 %0, -1, 0\n\tv_mbcnt_hi_u32_b32 %0, -1, %0" : "=v"(lane)); const int tid = wave * 64 + lane; (void)tid; \
    unsigned char* ws = ldptr<unsigned char>(lds, 29); float* out = ldptr<float>(lds, 28); (void)out; \
    const int gw = vcu * 8 + wave, gt = vcu * 512 + tid; (void)gw; (void)gt;

__global__ void __launch_bounds__(512, 2) fwd(Args args) {
    extern __shared__ __attribute__((aligned(16))) unsigned char lds_raw[];
    LAS unsigned char* lds = (LAS unsigned char*)lds_raw;
    const int tid0 = threadIdx.x, wave0 = __builtin_amdgcn_readfirstlane(tid0 >> 6);
    const int G = gridDim.x, bx = blockIdx.x;
    const int vcu0 = (G % 8 == 0) ? (bx % 8) * (G / 8) + bx / 8 : bx;
    const int NGW = G * 8, NGT = G * 512;
    volatile LAS unsigned* MISC = (volatile LAS unsigned*)(lds + MISC_OFF);
    for (int u = tid0; u < (LDS_BYTES - RING_BYTES) / 4; u += 512) ((LAS unsigned*)(lds + RING_BYTES))[u] = 0u;
    __syncthreads();
    if (tid0 == 0) {
#pragma unroll
        for (int i = 0; i < 28; ++i) *(LAS unsigned long long*)(lds + PTAB_OFF + 8 * i) = (unsigned long long)args.in[i];
        *(LAS unsigned long long*)(lds + PTAB_OFF + 8 * 28) = (unsigned long long)args.out;
        *(LAS unsigned long long*)(lds + PTAB_OFF + 8 * 29) = (unsigned long long)args.ws;
    }
    __syncthreads();
    (void)xcd_barrier_post((unsigned*)(args.ws + WS_CTL) + CW_BAR, MISC + 8);

#ifndef SKIP_P0
    {
        PHASE_BEGIN
        LAS unsigned char* scr = lds + wave * 16384;
        for (int it = gw; it < IT_IN; it += NGW) CONV_ITEM_A(0, it);
        for (int e = gt; e < DEPTH * 3 * 512 * 96; e += NGT) {
            const int k = e % 96, ch = (e / 96) % 512, mat = (e / (96 * 512)) % 3, l = e / (96 * 512 * 3);
            float v = 0.f;
            if (mat == 0) v = IN(I_W2)[((size_t)l * 96 + k) * 512 + ch];
            else if (mat == 1) v = IN(I_A2)[((size_t)l * 96 + k) * 512 + ch];
            else if (k < 64) v = IN(I_G2)[((size_t)l * 64 + k) * 512 + ch];
            G_WLT[e] = (bf16_t)f2bf(v);
        }
        for (int e = gt; e < 2056 * 8; e += NGT) {
            const int pi = e >> 3, i = e & 7; const int pos = pi < SEQ ? pi : PASTLEN + (pi - SEQ);
            const float inv = expf(-logf(500000.0f) * (float)i * 2.0f / 16.0f);
            const float ang = (float)pos * inv;
            G_ROPE[pi * 16 + i] = (float)cos((double)ang); G_ROPE[pi * 16 + 8 + i] = (float)sin((double)ang);
        }
        for (int m = gw; m < MTOT; m += NGW) {
            const float* xr = m < MP ? IN(I_XP) + (size_t)m * DM : IN(I_XS) + (size_t)(m - MP) * DM;
            float s = 0.f;
#pragma unroll
            for (int j = 0; j < 8; ++j) { const f32x4 v = *(const f32x4*)(xr + 4 * lane + 256 * j);
                u32x2 o; o.x = pk2(v[0], v[1]); o.y = pk2(v[2], v[3]); *(u32x2*)(G_XN + (size_t)m * DM + 4 * lane + 256 * j) = o;
                s += (v[0] * v[0] + v[1] * v[1]) + (v[2] * v[2] + v[3] * v[3]); }
            s = wave_sum(s); if (lane == 0) G_SSQ[m] = s;
        }
    }
#endif
    GRID_BAR();

    for (int l = 0; l < DEPTH; ++l) {
#ifndef SKIP_PIN
        _Pragma("unroll 1") for (int rep_ = 0; rep_ < REP_PIN; ++rep_) {
            PHASE_BEGIN
            pg8::Gemm g{G_XN, G_WIN + (size_t)l * INC * DM, MTOT, INC, DM, DM}; pg8::StaticOrder S; S.init(MTOT, INC, G, bx);
            pg8::EpiIn E; E.ssq = G_SSQ + (size_t)(2 * l) * MTOT; E.rope = G_ROPE; E.QA = G_QA; E.KA = G_KA; E.VA = G_VA; E.QC = G_QC; E.KC = G_KC; E.VC = G_VC; E.PB = G_PB;
            E.o_ak_p = out + O_AKP + (size_t)l * MP * 512; E.o_av_p = out + O_AVP + (size_t)l * MP * 512; E.o_ck_p = out + O_CKP + (size_t)l * NBATCH * 128 * 128; E.o_cv_p = out + O_CVP + (size_t)l * NBATCH * 128 * 128;
            E.o_sh_p = out + O_SHP + (size_t)l * NBATCH * BCOLS; E.o_ak_s = out + O_AKS + (size_t)l * MS * 512; E.o_av_s = out + O_AVS + (size_t)l * MS * 512;
            E.o_ck_s = out + O_CKS + (size_t)l * MS * 128; E.o_cv_s = out + O_CVS + (size_t)l * MS * 128; E.o_sh_s = out + O_SHS + (size_t)l * DECB * BCOLS;
            pg8::gemm_phase<pg8::EpiIn, pg8::StaticOrder, true, true>(lds, g, S, E, wave);
            constexpr int NIDLE = 256 - ((MTOT / 256) * (INC / 256) - 512);
            if (rep_ == 0 && bx >= 256 - NIDLE) {
                LAS unsigned char* scr = lds + wave * 16384;
                const int nit = (IT_A - IT_IN) + (l + 1 < DEPTH ? IT_IN : 0);
                for (int it = (bx - (256 - NIDLE)) * 8 + wave; it < nit; it += NIDLE * 8) { if (it < IT_A - IT_IN) CONV_ITEM_A(l, IT_IN + it); else CONV_ITEM_A(l + 1, it - (IT_A - IT_IN)); }
                for (int it = (bx - (256 - NIDLE)) * 8 + wave; it < IT_B / 2; it += NIDLE * 8) CONV_ITEM_B(l, it);
            }
        }
#endif
        GRID_BAR();

#ifndef SKIP_M1
        {
            PHASE_BEGIN
#ifndef SKIP_M1A
            _Pragma("unroll 1") for (int rep_ = 0; rep_ < REP_M1A; ++rep_) { PHASE_BEGIN
                RwkvW W; W.mu = IN(I_MU) + l * BCOLS; W.w0 = IN(I_W0) + l * 512; W.a0 = IN(I_A0) + l * 512; W.kk = IN(I_KK) + l * 512; W.ka = IN(I_KA) + l * 512; W.rk = IN(I_RK) + l * 512;
                W.wlt = G_WLT + (size_t)l * 3 * 512 * 96;
            for (int task = vcu; task < 256; task += G) {
                const int seg = task & 7, h = (task >> 3) & 7, b = task >> 6;
                const int prow = b * SEQ + seg * 256, th0 = (b * 8 + h) * SEQ + seg * 256;
                rwkv_stage_weights(lds, W.wlt, h, tid);
#pragma unroll 1
                for (int tt = 0; tt < 2; ++tt) {
                    const int p0 = prow + 128 * tt; const float* prev0 = (seg == 0 && tt == 0) ? nullptr : G_PB + (size_t)(p0 - 1) * BCOLS;
                    rwkv_prepass_tile(lds, G_PB, p0, prev0, 128, h, W, G_OPS, G_GG, G_BON, th0 + 128 * tt, tid, wave);
                }
                rwkv_scan(lds, G_OPS, th0, 256, nullptr, seg > 0, G_YZ + (size_t)th0 * 128, 128, G_ENDS + (size_t)task * 8192, G_ENDS + (size_t)task * 8192 + 4096, tid, wave);
            }
            }
#endif
#ifndef SKIP_M1B
            _Pragma("unroll 1") for (int rep_ = 0; rep_ < REP_M1B; ++rep_) { PHASE_BEGIN
                RwkvW W; W.mu = IN(I_MU) + l * BCOLS; W.w0 = IN(I_W0) + l * 512; W.a0 = IN(I_A0) + l * 512; W.kk = IN(I_KK) + l * 512; W.ka = IN(I_KA) + l * 512; W.rk = IN(I_RK) + l * 512;
                W.wlt = G_WLT + (size_t)l * 3 * 512 * 96;
            for (int task = vcu; task < 256; task += G) {
                const int h = task & 7, b = task >> 3; const int th0 = MP * 8 + task * 8;
                rwkv_stage_weights(lds, W.wlt, h, tid);
                rwkv_prepass_tile(lds, G_PB, MP + b * 8, IN(I_SHIFT) + ((size_t)l * DECB + b) * BCOLS, 8, h, W, G_OPS, G_GG, G_BON, th0, tid, wave);
                float* wo = out + O_WKVS + ((size_t)(l * DECB + b) * 8 + h) * 4096;
                rwkv_scan(lds, G_OPS, th0, 8, IN(I_WKV) + ((size_t)(l * DECB + b) * 8 + h) * 4096, false, G_YS + (size_t)task * 8 * 64, 64, wo, wo, tid, wave);
                {
                    const int t = wave, th = th0 + t;
                    rwkv_out_token(G_YS[(size_t)task * 512 + t * 64 + lane], IN(I_LNW)[l * 512 + h * 64 + lane], IN(I_LNB)[l * 512 + h * 64 + lane], G_BON[th], G_OPS[(size_t)th * 384 + 320 + lane], G_GG[(size_t)th * 64 + lane],
                                   G_MIX + (size_t)(MP + b * 8 + t) * DM + 512 + h * 64 + lane);
                }
            }
            }
#endif
#ifndef SKIP_M1C
            _Pragma("unroll 1") for (int rep_ = 0; rep_ < REP_M1C; ++rep_) { PHASE_BEGIN
            const int w = wave, fr = lane & 15, fq = lane >> 4;
            const int na = vcu < 128 ? 2 : 10;
#define A_TILE(k_) const int a_ = vcu < 128 ? vcu + 128 * (k_) : 256 + (vcu - 128) + 128 * (k_); \
                const int br = a_ >> 9, rem = a_ & 511, b = rem >> 7, h = (rem >> 4) & 7, u = rem & 15; \
                const int dil = br == 0 ? 1 : (br == 1 ? 4 : 16); \
                const int res = br == 0 ? 0 : (br == 1 ? (u >> 2) : u), qt = br == 0 ? u : (br == 1 ? (u & 3) : 0);
            u32x4 kr[4], vr[4];
            if (vcu < 128) {
                const int b = vcu >> 5, kvh = (vcu >> 4) & 1, qt = vcu & 15;
                band_load_kv(kr, vr, G_KC, G_VC, 128, kvh * 64, b * SEQ, 1, 0, 128 * qt, qt > 0, tid);
                band_store_kv(lds, kr, vr, tid);
                __syncthreads();
                { A_TILE(0) band_load_kv(kr, vr, G_KA, G_VA, 512, h * 64, b * SEQ, dil, res, 128 * qt, qt > 0, tid); }
                const int row = b * SEQ + 128 * qt + 16 * w + fr;
                const bf16_t* qp = G_QC + (size_t)row * 1024 + kvh * 512 + 8 * fq;
                bf16x8 qa = *(const bf16x8*)qp, qb = *(const bf16x8*)(qp + 32);
#pragma unroll 1
                for (int gq = 0; gq < 8; ++gq) {
                    const int qh = kvh * 8 + gq; f32x4 o[4]; float mrow, lrow;
                    const bf16x8 q0 = qa, q1 = qb;
                    if (gq + 1 < 8) { qa = *(const bf16x8*)(qp + (gq + 1) * 64); qb = *(const bf16x8*)(qp + (gq + 1) * 64 + 32); }
                    band_head(lds, q0, q1, qt > 0, w, lane, o, mrow, lrow);
                    const float lse = (mrow + __builtin_amdgcn_logf(lrow)) * LN2F;
                    const float sc = sigmoidf_(lse - IN(I_SINK)[l * 16 + qh]) / lrow;
#pragma unroll
                    for (int dt = 0; dt < 4; ++dt) { u32x2 ow; ow.x = pk2(o[dt][0] * sc, o[dt][1] * sc); ow.y = pk2(o[dt][2] * sc, o[dt][3] * sc);
                        *(u32x2*)(G_MIX + (size_t)row * DM + 1024 + qh * 64 + 16 * dt + 4 * fq) = ow; }
                }
            } else {
                A_TILE(0) band_load_kv(kr, vr, G_KA, G_VA, 512, h * 64, b * SEQ, dil, res, 128 * qt, qt > 0, tid);
            }
#pragma unroll 1
            for (int k = 0; k < na; ++k) {
                bf16x8 q0, q1;
                { A_TILE(k) const bf16_t* qp = G_QA + (size_t)(b * SEQ + dil * (128 * qt + 16 * w + fr) + res) * 512 + h * 64 + 8 * fq; q0 = *(const bf16x8*)qp; q1 = *(const bf16x8*)(qp + 32); }
                __syncthreads();
                band_store_kv(lds, kr, vr, tid);
                __syncthreads();
                if (k + 1 < na) { A_TILE(k + 1) band_load_kv(kr, vr, G_KA, G_VA, 512, h * 64, b * SEQ, dil, res, 128 * qt, qt > 0, tid); }
                A_TILE(k)
                const int row = b * SEQ + dil * (128 * qt + 16 * w + fr) + res;
                f32x4 o[4]; float mrow, lrow;
                band_head(lds, q0, q1, qt > 0, w, lane, o, mrow, lrow);
                const float inv = 1.0f / lrow;
#pragma unroll
                for (int dt = 0; dt < 4; ++dt) { u32x2 ow; ow.x = pk2(o[dt][0] * inv, o[dt][1] * inv); ow.y = pk2(o[dt][2] * inv, o[dt][3] * inv); *(u32x2*)(G_OA + ((size_t)br * MP + row) * 512 + h * 64 + 16 * dt + 4 * fq) = ow; }
                if (fq == 0) G_LSE[((size_t)br * MP + row) * 8 + h] = (mrow + __builtin_amdgcn_logf(lrow)) * LN2F;
            }
            __syncthreads();
#undef A_TILE
            }
#endif
#ifndef SKIP_M1D
            _Pragma("unroll 1") for (int rep_ = 0; rep_ < REP_M1D; ++rep_) { PHASE_BEGIN
            for (int wt = gw; wt < DECB * DECS * 8; wt += NGW) {
                const int h = wt & 7, t = (wt >> 3) & 7, b = wt >> 6; const int row = MP + b * 8 + t;
                const size_t cb = ((size_t)(l * DECB + b) * 2048) * 512 + h * 64, nb = ((size_t)(l * DECB + b) * 8) * 512 + h * 64;
                f32x4 o; float lse;
                dec_attn<3>(G_QA + (size_t)row * 512 + h * 64, IN(I_CAK) + cb, IN(I_CAV) + cb, out + O_AKS + nb, out + O_AVS + nb, 512, 2048, t, lane, o, lse);
                if (lane < 16) { u32x2 ow; ow.x = pk2(o[0], o[1]); ow.y = pk2(o[2], o[3]); *(u32x2*)(G_MIX + (size_t)row * DM + h * 64 + 4 * lane) = ow; }
            }
            for (int wt = gw; wt < DECB * DECS * 16; wt += NGW) {
                const int qh = wt & 15, t = (wt >> 4) & 7, b = wt >> 7; const int row = MP + b * 8 + t, kvh = qh >> 3;
                const size_t cb = ((size_t)(l * DECB + b) * 128) * 128 + kvh * 64, nb = ((size_t)(l * DECB + b) * 8) * 128 + kvh * 64;
                f32x4 o; float lse;
                dec_attn<1>(G_QC + (size_t)row * 1024 + qh * 64, IN(I_CCK) + cb, IN(I_CCV) + cb, out + O_CKS + nb, out + O_CVS + nb, 128, 128, t, lane, o, lse);
                const float sc = sigmoidf_(lse - IN(I_SINK)[l * 16 + qh]);
                if (lane < 16) { u32x2 ow; ow.x = pk2(o[0] * sc, o[1] * sc); ow.y = pk2(o[2] * sc, o[3] * sc); *(u32x2*)(G_MIX + (size_t)row * DM + 1024 + qh * 64 + 4 * lane) = ow; }
            }
            }
#endif
        }
#endif
        GRID_BAR();

#ifndef SKIP_M2
        _Pragma("unroll 1") for (int rep_ = 0; rep_ < REP_M2; ++rep_) {
            PHASE_BEGIN
#pragma unroll 4
            for (int it = gt; it < MP * 64; it += NGT) {
                const int dc = it & 7, h = (it >> 3) & 7, row = it >> 6;
                const float l0 = G_LSE[((size_t)0 * MP + row) * 8 + h], l1 = G_LSE[((size_t)1 * MP + row) * 8 + h], l2 = G_LSE[((size_t)2 * MP + row) * 8 + h];
                const float mx = fmaxf(l0, fmaxf(l1, l2)); float w0 = __builtin_amdgcn_exp2f(1.4426950408889634f * (l0 - mx)), w1 = __builtin_amdgcn_exp2f(1.4426950408889634f * (l1 - mx)), w2 = __builtin_amdgcn_exp2f(1.4426950408889634f * (l2 - mx)); const float inv = 1.0f / (w0 + w1 + w2); w0 *= inv; w1 *= inv; w2 *= inv;
                const size_t off = (size_t)row * 512 + h * 64 + dc * 8;
                const u32x4 ua = *(const u32x4*)(G_OA + off), ub = *(const u32x4*)(G_OA + (size_t)MP * 512 + off), uc = *(const u32x4*)(G_OA + (size_t)2 * MP * 512 + off);
#define BF_LO(x) __builtin_bit_cast(float, (x) << 16)
#define BF_HI(x) __builtin_bit_cast(float, (x) & 0xffff0000u)
                const f32x4 a0 = (f32x4){BF_LO(ua.x), BF_HI(ua.x), BF_LO(ua.y), BF_HI(ua.y)}, a1 = (f32x4){BF_LO(ua.z), BF_HI(ua.z), BF_LO(ua.w), BF_HI(ua.w)};
                const f32x4 b0 = (f32x4){BF_LO(ub.x), BF_HI(ub.x), BF_LO(ub.y), BF_HI(ub.y)}, b1 = (f32x4){BF_LO(ub.z), BF_HI(ub.z), BF_LO(ub.w), BF_HI(ub.w)};
                const f32x4 c0 = (f32x4){BF_LO(uc.x), BF_HI(uc.x), BF_LO(uc.y), BF_HI(uc.y)}, c1 = (f32x4){BF_LO(uc.z), BF_HI(uc.z), BF_LO(uc.w), BF_HI(uc.w)};
#undef BF_LO
#undef BF_HI
                const f32x4 r0 = a0 * w0 + b0 * w1 + c0 * w2, r1 = a1 * w0 + b1 * w1 + c1 * w2;
                u32x4 ow; ow.x = pk2(r0[0], r0[1]); ow.y = pk2(r0[2], r0[3]); ow.z = pk2(r1[0], r1[1]); ow.w = pk2(r1[2], r1[3]);
                *(u32x4*)(G_MIX + (size_t)row * DM + h * 64 + dc * 8) = ow;
            }
            LAS float* Sl = (LAS float*)lds;
            LAS float* Pl = (LAS float*)(lds + 17408);
            LAS float* PT = (LAS float*)(lds + 17408 + 20480 + wave * 8192);
            constexpr int PS = 80;
#pragma unroll 1
            for (int task = vcu; task < 256; task += G) {
                const int seg = task & 7, h = (task >> 3) & 7, b = task >> 6;
                const int th0 = (b * 8 + h) * SEQ + seg * 256, prow = b * SEQ + seg * 256;
                const int fi = tid >> 3, fj = (tid & 7) * 8;
                const int tr = wave >> 1, tc0 = (wave & 1) * 2, lr = lane & 15, lq = lane >> 4;
                const int nfold = seg;
                f32x4 pn0, pn1, zt0, zt1;
                __syncthreads();
                for (int i = tid; i < 64 * 68; i += 512) Sl[i] = 0.f;
#define FOLD_LOAD(c) do { const float* ze_ = G_ENDS + (size_t)(task - seg + (c)) * 8192; const float* pe_ = ze_ + 4096; \
                    pn0 = *(const f32x4*)(pe_ + tid * 8); pn1 = *(const f32x4*)(pe_ + tid * 8 + 4); \
                    _Pragma("unroll") for (int i_ = 0; i_ < 4; ++i_) { zt0[i_] = ze_[(tr * 16 + 4 * lq + i_) * 64 + tc0 * 16 + lr]; zt1[i_] = ze_[(tr * 16 + 4 * lq + i_) * 64 + tc0 * 16 + 16 + lr]; } } while (0)
#define FOLD_STEP(has_next, cn) do { \
                    __syncthreads(); \
                    *(LAS f32x4*)(Pl + fi * PS + fj) = pn0; *(LAS f32x4*)(Pl + fi * PS + fj + 4) = pn1; \
                    f32x4 a0 = zt0, a1 = zt1; \
                    __syncthreads(); \
                    if (has_next) FOLD_LOAD(cn); \
                    _Pragma("unroll") for (int kb = 0; kb < 16; ++kb) { \
                        const float av = Sl[(tr * 16 + lr) * 68 + kb * 4 + lq]; \
                        const float b0 = Pl[(kb * 4 + lq) * PS + tc0 * 16 + lr], b1 = Pl[(kb * 4 + lq) * PS + tc0 * 16 + 16 + lr]; \
                        a0 = __builtin_amdgcn_mfma_f32_16x16x4f32(av, b0, a0, 0, 0, 0); a1 = __builtin_amdgcn_mfma_f32_16x16x4f32(av, b1, a1, 0, 0, 0); } \
                    __syncthreads(); \
                    _Pragma("unroll") for (int i_ = 0; i_ < 4; ++i_) { Sl[(tr * 16 + 4 * lq + i_) * 68 + tc0 * 16 + lr] = a0[i_]; Sl[(tr * 16 + 4 * lq + i_) * 68 + tc0 * 16 + 16 + lr] = a1[i_]; } } while (0)
                if (nfold > 0) FOLD_LOAD(0);
#pragma unroll 1
                for (int c = 0; c < nfold; ++c) FOLD_STEP(c + 1 < nfold, c + 1);
                if (seg == 7) FOLD_LOAD(7);
                __syncthreads();
                {
                    const int tb = th0 + 32 * wave;
                    const float lw = IN(I_LNW)[l * 512 + h * 64 + lane], lb = IN(I_LNB)[l * 512 + h * 64 + lane];
                    if (seg > 0) {
#pragma unroll 16
                        for (int tk = 0; tk < 32; ++tk) PT[tk * 64 + lane] = G_YZ[(size_t)(tb + tk) * 128 + 64 + lane];
                        LDS_WAIT(); asm volatile("" ::: "memory");
                    }
                    float yv[4], bo[4], vv[4], gg[4], yn[4], bn[4], vn[4], gn[4];
#pragma unroll
                    for (int u = 0; u < 4; ++u) { const int th = tb + u; yv[u] = G_YZ[(size_t)th * 128 + lane]; bo[u] = G_BON[th]; vv[u] = G_OPS[(size_t)th * 384 + 320 + lane]; gg[u] = G_GG[(size_t)th * 64 + lane]; yn[u] = bn[u] = vn[u] = gn[u] = 0.f; }
#pragma unroll 1
                    for (int t4 = 0; t4 < 32; t4 += 4) {
                        if (t4 + 4 < 32) {
#pragma unroll
                            for (int u = 0; u < 4; ++u) { const int th = tb + t4 + 4 + u; yn[u] = G_YZ[(size_t)th * 128 + lane]; bn[u] = G_BON[th]; vn[u] = G_OPS[(size_t)th * 384 + 320 + lane]; gn[u] = G_GG[(size_t)th * 64 + lane]; }
                        }
#pragma unroll
                        for (int u = 0; u < 4; ++u) {
                            float y = yv[u];
                            if (seg > 0) {
                                float y2 = 0.f;
#pragma unroll
                                for (int q = 0; q < 16; ++q) { const f32x4 p4 = *(const LAS f32x4*)(PT + (t4 + u) * 64 + 4 * q), s4 = *(const LAS f32x4*)(Sl + lane * 68 + 4 * q); y += s4[0] * p4[0] + s4[1] * p4[1]; y2 += s4[2] * p4[2] + s4[3] * p4[3]; }
                                y += y2;
                            }
                            rwkv_out_token(y, lw, lb, bo[u], vv[u], gg[u], G_MIX + (size_t)(prow + 32 * wave + t4 + u) * DM + 512 + h * 64 + lane);
                        }
#pragma unroll
                        for (int u = 0; u < 4; ++u) { yv[u] = yn[u]; bo[u] = bn[u]; vv[u] = vn[u]; gg[u] = gn[u]; }
                    }
                }
                if (seg == 7) { FOLD_STEP(false, 0); __syncthreads(); float* wo = out + O_WKVP + ((size_t)(l * NBATCH + b) * 8 + h) * 4096 + fi * 64 + fj; *(f32x4*)wo = *(const LAS f32x4*)(Sl + fi * 68 + fj); *(f32x4*)(wo + 4) = *(const LAS f32x4*)(Sl + fi * 68 + fj + 4); }
#undef FOLD_STEP
#undef FOLD_LOAD
            }
            __syncthreads();
            if (rep_ == 0) {
                const int seg = vcu & 7, grp = vcu >> 3;
                const int cn = (int)((0x5080a0d0f1213ull >> (8 * seg)) & 0xffu), co = (int)((0x58534b4134251300ull >> (8 * seg)) & 0xffu);
                LAS unsigned char* scr = lds + wave * 16384;
                for (int j = wave; j < cn; j += 8) { const int it = IT_B / 2 + grp * 88 + co + j; CONV_ITEM_B(l, it); }
                __syncthreads();
            }
            {
                const int task = vcu, seg = task & 7, bh = task >> 3;
                int kslice = 512; asm volatile("" : "+s"(kslice));
                const int pn = bh & 7, ks = bh >> 3;
                pg8::OneUnit S2; S2.pm = 0; S2.pn = pn; S2.have = (rep_ == 0) && seg == 0;
                pg8::Gemm g2{G_MIX + (size_t)MP * DM + ks * 512, G_WOUT + (size_t)l * DM * DM + ks * 512, MS, DM, kslice, DM};
                pg8::EpiPart E2; E2.P = G_PART + (size_t)ks * MS * DM;
                pg8::gemm_phase<pg8::EpiPart, pg8::OneUnit, true, true>(lds, g2, S2, E2, wave);
            }
        }
#endif
        GRID_BAR();

#ifndef SKIP_POUT
        _Pragma("unroll 1") for (int rep_ = 0; rep_ < REP_POUT; ++rep_) {
            PHASE_BEGIN
            if (rep_ == 0) {
                const int row = MP + vcu; const int c = 256 * wave + 4 * lane;
                f32x4 v = l == 0 ? *(const f32x4*)(IN(I_XS) + (size_t)vcu * DM + c) : *(const f32x4*)(G_X + (size_t)row * DM + c);
                const f32x4 p0 = *(const f32x4*)(G_PART + ((size_t)0 * MS + vcu) * DM + c), p1 = *(const f32x4*)(G_PART + ((size_t)1 * MS + vcu) * DM + c);
                const f32x4 p2 = *(const f32x4*)(G_PART + ((size_t)2 * MS + vcu) * DM + c), p3 = *(const f32x4*)(G_PART + ((size_t)3 * MS + vcu) * DM + c);
                v += (p0 + p1) + (p2 + p3);
                *(f32x4*)(G_X + (size_t)row * DM + c) = v; u32x2 o; o.x = pk2(v[0], v[1]); o.y = pk2(v[2], v[3]); *(u32x2*)(G_XN + (size_t)row * DM + c) = o;
                const float s = wave_sum((v[0] * v[0] + v[1] * v[1]) + (v[2] * v[2] + v[3] * v[3]));
                if (lane == 0) unsafeAtomicAdd(G_SSQ + (size_t)(2 * l + 1) * MTOT + row, s);
            }
            pg8::Gemm g{G_MIX, G_WOUT + (size_t)l * DM * DM, MP, DM, DM, DM}; pg8::StaticOrder S; S.init(MP, DM, G, bx);
            pg8::EpiRes E; E.X = G_X; E.Xin = l == 0 ? IN(I_XP) : G_X; E.XN = G_XN; E.ssq_next = G_SSQ + (size_t)(2 * l + 1) * MTOT; E.dry = (rep_ + 1 < REP_POUT);
            pg8::gemm_phase<pg8::EpiRes, pg8::StaticOrder, true, true>(lds, g, S, E, wave);
        }
#endif
        GRID_BAR();
#ifndef SKIP_PGU
        _Pragma("unroll 1") for (int rep_ = 0; rep_ < REP_PGU; ++rep_) {
            PHASE_BEGIN
            pg8::Gemm g{G_XN, G_WGU + (size_t)l * NGU * DM, MTOT, NGU, DM, DM}; pg8::GuOrder S; S.init(G, bx);
            pg8::EpiGU E; E.ssq = G_SSQ + (size_t)(2 * l + 1) * MTOT; E.ACT = G_ACT;
            pg8::gemm_phase<pg8::EpiGU, pg8::GuOrder, true, true>(lds, g, S, E, wave);
            if (bx >= pg8::GuOrder::SPEC0 && rep_ == 0) {
                const int k = bx - pg8::GuOrder::SPEC0;
                int kslice = 256; asm volatile("" : "+s"(kslice));
                pg8::Gemm g2{G_ACT + (size_t)MP * FF + k * 256, G_WDN + (size_t)l * DM * FF + k * 256, MS, DM, kslice, FF};
                pg8::RowUnits S2; S2.nt = DM / 256; S2.have = true;
                pg8::EpiPart E2; E2.P = G_PART + (size_t)k * MS * DM;
                pg8::gemm_phase<pg8::EpiPart, pg8::RowUnits, true, true>(lds, g2, S2, E2, wave);
            }
        }
#endif
        GRID_BAR();
#ifndef SKIP_PDN
        _Pragma("unroll 1") for (int rep_ = 0; rep_ < REP_PDN; ++rep_) {
            PHASE_BEGIN
            if (rep_ == 0) {
                const int row = MP + vcu; const int c = 256 * wave + 4 * lane;
                f32x4 v = *(const f32x4*)(G_X + (size_t)row * DM + c);
                f32x4 pp[22];
#pragma unroll
                for (int kc = 0; kc < 22; ++kc) pp[kc] = *(const f32x4*)(G_PART + ((size_t)kc * MS + vcu) * DM + c);
#pragma unroll
                for (int kc = 0; kc < 22; ++kc) v += pp[kc];
                float s = wave_sum((v[0] * v[0] + v[1] * v[1]) + (v[2] * v[2] + v[3] * v[3]));
                if (l + 1 < DEPTH || G != 256) {
                    *(f32x4*)(G_X + (size_t)row * DM + c) = v; u32x2 o; o.x = pk2(v[0], v[1]); o.y = pk2(v[2], v[3]); *(u32x2*)(G_XN + (size_t)row * DM + c) = o;
                    if (lane == 0) unsafeAtomicAdd(G_SSQ + (size_t)(2 * l + 2) * MTOT + row, s);
                } else {
                    volatile LAS float* sl = (volatile LAS float*)(lds + MISC_OFF + 128);
                    if (lane == 0) sl[wave] = s;
                    __syncthreads();
                    const float tot = ((sl[0] + sl[1]) + (sl[2] + sl[3])) + ((sl[4] + sl[5]) + (sl[6] + sl[7]));
                    const float rstd = rsqrtf(tot * (1.0f / DM) + RMS_EPS);
                    *(f32x4*)(out + (size_t)row * DM + c) = v * rstd * *(const f32x4*)(IN(I_GFIN) + c);
                    __syncthreads();
                }
            }
            pg8::Gemm g{G_ACT, G_WDN + (size_t)l * DM * FF, MP, DM, FF, FF}; pg8::StaticOrder S; S.init(MP, DM, G, bx);
            if (l + 1 < DEPTH || G != 256) {
                pg8::EpiRes E; E.X = G_X; E.Xin = G_X; E.XN = G_XN; E.ssq_next = G_SSQ + (size_t)(2 * l + 2) * MTOT; E.dry = (rep_ + 1 < REP_PDN);
                pg8::gemm_phase<pg8::EpiRes, pg8::StaticOrder, true, true>(lds, g, S, E, wave);
            } else {
                pg8::EpiFinal E; E.X = G_X; E.OUT = out; E.gf = IN(I_GFIN); E.ssq = G_SSQ + (size_t)(2 * DEPTH) * MTOT; E.cnt = (unsigned*)(ws + WS_CTL) + CW_FIN;
                pg8::gemm_phase<pg8::EpiFinal, pg8::StaticOrder, true, true>(lds, g, S, E, wave);
            }
        }
#endif
        if (l + 1 < DEPTH || G != 256) GRID_BAR();
    }
    if (G != 256) {
        PHASE_BEGIN
        const float* ssq = G_SSQ + (size_t)(2 * DEPTH) * MTOT; const float* gf = IN(I_GFIN);
        for (int m = gw; m < MTOT; m += NGW) {
            const float rstd = rsqrtf(ssq[m] * (1.0f / DM) + RMS_EPS);
#pragma unroll
            for (int j = 0; j < 8; ++j) { const int c = 4 * lane + 256 * j; const f32x4 v = *(const f32x4*)(G_X + (size_t)m * DM + c), gg = *(const f32x4*)(gf + c);
                *(f32x4*)(out + (size_t)m * DM + c) = v * rstd * gg; }
        }
    }
}

extern "C" void kernel_launch(void* const* d_in, const int* in_sizes, int n_in, void* d_out, int out_size, void* d_ws, size_t ws_size, hipStream_t stream) {
    static int grid = 0;
    if (grid == 0) {
        if (n_in != 28 || (size_t)out_size != O_END || ws_size < WS_END) { fprintf(stderr, "kernel_launch: unexpected shapes: n_in %d out %d (want %zu) ws %zu (want >= %zu)\n", n_in, out_size, (size_t)O_END, ws_size, (size_t)WS_END); grid = -1; return; }
        int dev = 0, cus = 0;
        if (hipGetDevice(&dev) != hipSuccess || hipDeviceGetAttribute(&cus, hipDeviceAttributeMultiprocessorCount, dev) != hipSuccess) { grid = -1; return; }
        if (hipFuncSetAttribute((const void*)fwd, hipFuncAttributeMaxDynamicSharedMemorySize, LDS_BYTES) != hipSuccess) { fprintf(stderr, "kernel_launch: hipFuncSetAttribute failed\n"); grid = -1; return; }
        int per_cu = 0;
        if (hipOccupancyMaxActiveBlocksPerMultiprocessor(&per_cu, (const void*)fwd, 512, LDS_BYTES) != hipSuccess || per_cu < 1) { fprintf(stderr, "kernel_launch: occupancy query says %d blocks per CU\n", per_cu); }
        (void)hipGetLastError();
        grid = cus;
    }
    if (grid < 0) return;
    if (hipMemsetAsync((char*)d_ws + WS_CTL, 0, CTL_ZERO_BYTES, stream) != hipSuccess) return;
    Args a{};
    for (int i = 0; i < 28; ++i) a.in[i] = (const float*)d_in[i];
    a.out = (float*)d_out; a.ws = (unsigned char*)d_ws;
    hipLaunchKernelGGL(fwd, dim3(grid), dim3(512), LDS_BYTES, stream, a);
}
```
